# Optimizing an MI355X kernel written in HIP

```python
import jax, jax.numpy as jnp
from jax import lax
import numpy as np

D_MODEL = 1024
BATCH = 16
SEQ = 256
DEPTH = 4
DEC_BATCH = 4
DEC_SEQ = 2048
PAST_LEN = 256

GRID_W = 64
D_RNN = 1024
N_LRU_HEADS = 4
LRU_HEAD_DIM = D_RNN // N_LRU_HEADS
LRU_C = 8.0
CONV_W = 4
CONV_LEFT = 2
CONV_RIGHT = 1
D_FNET = 512
N_FNET_GROUPS = 8
FNET_GROUP_DIM = D_FNET // N_FNET_GROUPS
N_IN = 2 * D_RNN + D_FNET + 2 * D_MODEL
D_FF = ((8 * D_MODEL + 3 * 256 - 1) // (3 * 256)) * 256
EPS = 1e-6

kernel_name = "hybrid_rglru_fnet_diffusion_step"


def rmsnorm(x, g):
    xf = x.astype(jnp.float32)
    y = xf * lax.rsqrt(jnp.mean(xf * xf, axis=-1, keepdims=True) + EPS)
    return (y * g.astype(jnp.float32)).astype(x.dtype)


def adaln_params(c_silu, ada_w, ada_b):
    mod = c_silu @ ada_w + ada_b
    return [m[:, None, :] for m in jnp.split(mod, 6, axis=-1)]


def depthwise_conv(x, w, b):
    L = x.shape[1]
    xp = jnp.pad(x, ((0, 0), (CONV_LEFT, CONV_RIGHT), (0, 0)))
    y = b
    for k in range(CONV_W):
        y = y + xp[:, k:k + L, :] * w[k]
    return y


def _lin_combine(e1, e2):
    a1, b1 = e1
    a2, b2 = e2
    return a1 * a2, a2 * b1 + b2


def rglru_direction(x, wa, ba, wx, bx, lam, h0, reverse):
    B, L, _ = x.shape
    xh = x.reshape(B, L, N_LRU_HEADS, LRU_HEAD_DIM)
    r = jax.nn.sigmoid(jnp.einsum('blhd,hde->blhe', xh, wa).reshape(B, L, D_RNN) + ba)
    i = jax.nn.sigmoid(jnp.einsum('blhd,hde->blhe', xh, wx).reshape(B, L, D_RNN) + bx)
    log_a = -LRU_C * r * jax.nn.softplus(-lam)
    a = jnp.exp(log_a)
    mult = jnp.sqrt(-jnp.expm1(2.0 * log_a))
    b = mult * (i * x)
    if reverse:
        b = b.at[:, -1].add(a[:, -1] * h0)
    else:
        b = b.at[:, 0].add(a[:, 0] * h0)
    _, h = lax.associative_scan(_lin_combine, (a, b), axis=1, reverse=reverse)
    return h


def rglru_bidir(x, wa, ba, wx, bx, lam, h0_f, h0_b):
    xf = x.astype(jnp.float32)
    h_f = rglru_direction(xf, wa[0].astype(jnp.float32), ba[0].astype(jnp.float32), wx[0].astype(jnp.float32),
                          bx[0].astype(jnp.float32), lam[0].astype(jnp.float32), h0_f.astype(jnp.float32), False)
    h_b = rglru_direction(xf, wa[1].astype(jnp.float32), ba[1].astype(jnp.float32), wx[1].astype(jnp.float32),
                          bx[1].astype(jnp.float32), lam[1].astype(jnp.float32), h0_b.astype(jnp.float32), True)
    out = (h_f + h_b).astype(x.dtype)
    return out, h_f[:, -1].astype(x.dtype), h_b[:, 0].astype(x.dtype)


def fourier_mix(xf, on_grid):
    B, L, _ = xf.shape
    xg = xf.astype(jnp.float32).reshape(B, L, N_FNET_GROUPS, FNET_GROUP_DIM)
    if on_grid:
        rows = L // GRID_W
        xg = xg.reshape(B, rows, GRID_W, N_FNET_GROUPS, FNET_GROUP_DIM)
        f = jnp.fft.fftn(xg, axes=(1, 2, 4), norm="ortho").real
    else:
        f = jnp.fft.fftn(xg, axes=(1, 3), norm="ortho").real
    return f.reshape(B, L, D_FNET).astype(xf.dtype)


def block(x, mod, h0_f, h0_b, on_grid, norm1_g, norm2_g, w_in, b_in, conv_w, conv_b, lru_wa, lru_ba, lru_wx,
          lru_bx, lru_lambda, w_lru_out, w_fnet_out, w_out, ffn_w_in, ffn_w_out):
    shift1, scale1, gate1, shift2, scale2, gate2 = mod
    h = rmsnorm(x, norm1_g) * (1.0 + scale1) + shift1
    z = h @ w_in + b_in
    x_r = z[..., :D_RNN]
    y_r = z[..., D_RNN:2 * D_RNN]
    x_f = z[..., 2 * D_RNN:2 * D_RNN + D_FNET]
    g = jax.nn.sigmoid(z[..., 2 * D_RNN + D_FNET:])
    g_a = g[..., :D_MODEL]
    g_b = g[..., D_MODEL:]
    x_r = depthwise_conv(x_r, conv_w, conv_b)
    rec, hf_last, hb_first = rglru_bidir(x_r, lru_wa, lru_ba, lru_wx, lru_bx, lru_lambda, h0_f, h0_b)
    out_a = (rec * jax.nn.gelu(y_r)) @ w_lru_out
    out_b = fourier_mix(x_f, on_grid) @ w_fnet_out
    mixed = (g_a * out_a + g_b * out_b) @ w_out
    x = x + gate1 * mixed
    h2 = rmsnorm(x, norm2_g) * (1.0 + scale2) + shift2
    uv = h2 @ ffn_w_in
    u = uv[..., :D_FF]
    v = uv[..., D_FF:]
    x = x + gate2 * ((jax.nn.silu(u) * v) @ ffn_w_out)
    return x, hf_last, hb_first


def setup_inputs(seed: int = 0) -> dict:
    key = jax.random.key(seed)
    ks = jax.random.split(key, 26)
    f32 = jnp.float32
    nrm = lambda k, s, sc: jax.random.normal(k, s, f32) * sc
    u = jax.random.uniform(ks[15], (DEPTH, 2, D_RNN), f32, minval=0.9, maxval=0.999)
    a0 = u ** (1.0 / LRU_C)
    lru_lambda = jnp.log(a0) - jnp.log1p(-a0)
    return {
        "x_prompt": nrm(ks[0], (BATCH, SEQ, D_MODEL), 1.0),
        "x_sample": nrm(ks[1], (DEC_BATCH, DEC_SEQ, D_MODEL), 1.0),
        "state_lru": nrm(ks[2], (DEC_BATCH, DEPTH, 2, D_RNN), 0.5),
        "c": nrm(ks[3], (DEC_BATCH, D_MODEL), 1.0),
        "c_ctx": nrm(ks[4], (D_MODEL,), 1.0),
        "norm1_g": 1.0 + nrm(ks[5], (DEPTH, D_MODEL), 0.02),
        "norm2_g": 1.0 + nrm(ks[6], (DEPTH, D_MODEL), 0.02),
        "ada_w": nrm(ks[7], (DEPTH, D_MODEL, 6 * D_MODEL), 0.02),
        "ada_b": nrm(ks[8], (DEPTH, 6 * D_MODEL), 0.02),
        "w_in": nrm(ks[9], (DEPTH, D_MODEL, N_IN), D_MODEL ** -0.5),
        "b_in": nrm(ks[10], (DEPTH, N_IN), 0.02),
        "conv_w": nrm(ks[11], (DEPTH, CONV_W, D_RNN), CONV_W ** -0.5),
        "conv_b": nrm(ks[12], (DEPTH, D_RNN), 0.02),
        "lru_wa": nrm(ks[13], (DEPTH, 2, N_LRU_HEADS, LRU_HEAD_DIM, LRU_HEAD_DIM), LRU_HEAD_DIM ** -0.5),
        "lru_ba": nrm(ks[14], (DEPTH, 2, D_RNN), 0.02),
        "lru_wx": nrm(ks[16], (DEPTH, 2, N_LRU_HEADS, LRU_HEAD_DIM, LRU_HEAD_DIM), LRU_HEAD_DIM ** -0.5),
        "lru_bx": nrm(ks[17], (DEPTH, 2, D_RNN), 0.02),
        "lru_lambda": lru_lambda,
        "w_lru_out": nrm(ks[18], (DEPTH, D_RNN, D_MODEL), D_RNN ** -0.5),
        "w_fnet_out": nrm(ks[19], (DEPTH, D_FNET, D_MODEL), D_FNET ** -0.5),
        "w_out": nrm(ks[20], (DEPTH, D_MODEL, D_MODEL), D_MODEL ** -0.5),
        "ffn_w_in": nrm(ks[21], (DEPTH, D_MODEL, 2 * D_FF), D_MODEL ** -0.5),
        "ffn_w_out": nrm(ks[22], (DEPTH, D_FF, D_MODEL), D_FF ** -0.5),
        "final_g": 1.0 + nrm(ks[23], (D_MODEL,), 0.02),
    }


def reference(x_prompt, x_sample, state_lru, c, c_ctx, norm1_g, norm2_g, ada_w, ada_b, w_in, b_in, conv_w, conv_b,
              lru_wa, lru_ba, lru_wx, lru_bx, lru_lambda, w_lru_out, w_fnet_out, w_out, ffn_w_in, ffn_w_out,
              final_g):
    xp = x_prompt
    xs = x_sample
    B = x_prompt.shape[0]
    zeros = jnp.zeros((B, D_RNN), x_prompt.dtype)
    c_ctx_silu = jax.nn.silu(c_ctx)[None, :]
    c_silu = jax.nn.silu(c)
    layer_states = []
    for l in range(DEPTH):
        lp = (norm1_g[l], norm2_g[l], w_in[l], b_in[l], conv_w[l], conv_b[l], lru_wa[l], lru_ba[l], lru_wx[l],
              lru_bx[l], lru_lambda[l], w_lru_out[l], w_fnet_out[l], w_out[l], ffn_w_in[l], ffn_w_out[l])
        mod_ctx = adaln_params(c_ctx_silu, ada_w[l], ada_b[l])
        mod_lat = adaln_params(c_silu, ada_w[l], ada_b[l])
        xp, hf_last, hb_first = block(xp, mod_ctx, zeros, zeros, False, *lp)
        layer_states.append(jnp.stack([hf_last, hb_first], axis=1))
        xs, _, _ = block(xs, mod_lat, state_lru[:, l, 0], state_lru[:, l, 1], True, *lp)
    new_state_lru = jnp.stack(layer_states, axis=1)
    y_prompt = rmsnorm(xp, final_g)
    y_sample = rmsnorm(xs, final_g)
    return (y_prompt, y_sample, new_state_lru)
```

```cpp
#include <hip/hip_runtime.h>
#include <hip/hip_cooperative_groups.h>
#include <cstdio>
#include <cstdint>
namespace cg = cooperative_groups;

#ifndef COOP
#define COOP 1
#endif
#ifndef REP_MASK
#define REP_MASK 0
#endif
#ifndef SYNC_REP
#define SYNC_REP 1
#endif

#define LAS __attribute__((address_space(3)))
typedef unsigned short bf16_t;
typedef short bf16x8 __attribute__((ext_vector_type(8)));
typedef float f32x4 __attribute__((ext_vector_type(4)));
typedef float f32x2 __attribute__((ext_vector_type(2)));
typedef unsigned u32x4 __attribute__((ext_vector_type(4)));
typedef unsigned u32x2 __attribute__((ext_vector_type(2)));

constexpr int T = 12288, TCTX = 4096, D = 1024, NIN = 4608, NIN5 = 5120, DFF = 2816;
constexpr int NCH = 768;
constexpr int YLD = 2 * T;

constexpr size_t AL(size_t x) { return (x + 255) & ~(size_t)255; }
constexpr size_t WS_CTL = 0;
constexpr size_t WS_MOD = 16384;
constexpr size_t WS_BIAS = AL(WS_MOD + 4 * 5 * 6144 * 4);
constexpr size_t WS_SP = AL(WS_BIAS + NIN5 * 4);
constexpr size_t WS_DCTX = AL(WS_SP + 2 * 1024 * 4);
constexpr size_t WS_DLAT = AL(WS_DCTX + 256 * 4096 * 2);
constexpr size_t WS_WIN = AL(WS_DLAT + (size_t)2048 * 4096 * 2);
constexpr size_t WS_WG = AL(WS_WIN + (size_t)NIN5 * 1024 * 2);
constexpr size_t WS_WLOFO = AL(WS_WG + (size_t)4 * 1024 * 256 * 2);
constexpr size_t WS_WOUT = AL(WS_WLOFO + (size_t)1024 * 1536 * 2);
constexpr size_t WS_WFFI = AL(WS_WOUT + (size_t)1024 * 1024 * 2);
constexpr size_t WS_WFFO = AL(WS_WFFI + (size_t)5632 * 1024 * 2);
constexpr size_t WS_H = AL(WS_WFFO + (size_t)1024 * 2816 * 2);
constexpr size_t WS_XR = AL(WS_H + (size_t)T * 1024 * 2);
constexpr size_t WS_FFP = WS_H;
constexpr size_t WS_GY = AL(WS_XR + (size_t)T * 1024 * 2);
constexpr size_t WS_YT = AL(WS_GY + (size_t)T * 1024 * 2);
constexpr size_t WS_SG = AL(WS_YT + (size_t)512 * YLD * 2);
constexpr size_t WS_XC = AL(WS_SG + (size_t)T * 2048 * 2);
constexpr size_t WS_RGFF = AL(WS_XC + (size_t)T * 1024 * 2);
constexpr size_t WS_BIG = AL(WS_RGFF + (size_t)T * 1536 * 2);
constexpr size_t WS_LA = WS_BIG;
constexpr size_t WS_BB = WS_BIG + (size_t)2 * T * 1024 * 2;
constexpr size_t WS_SUMM = AL(WS_BIG + (size_t)4 * T * 1024 * 2);
constexpr size_t WS_CARRY = AL(WS_SUMM + (size_t)2 * NCH * 1024 * 8);
constexpr size_t WS_BM1 = AL(WS_CARRY + (size_t)2 * NCH * 1024 * 4);
constexpr size_t WS_BM2 = AL(WS_BM1 + (size_t)5 * NIN5 * 4);
constexpr size_t WS_RSS = AL(WS_BM2 + (size_t)5 * 5632 * 4);
constexpr size_t WS_XB = AL(WS_RSS + (size_t)T * 16 * 4);
constexpr size_t WS_END = AL(WS_XB + (size_t)T * 1024 * 2);

struct Params {
    const float *x_prompt, *x_sample, *state_lru, *c, *c_ctx, *norm1_g, *norm2_g, *ada_w, *ada_b, *w_in, *b_in, *conv_w, *conv_b, *lru_wa, *lru_ba, *lru_wx,
        *lru_bx, *lru_lambda, *w_lru_out, *w_fnet_out, *w_out, *ffn_w_in, *ffn_w_out, *final_g;
    float* out;
    unsigned char* ws;
    int st_lo, st_hi;
    int pad0, pad1;
};

__device__ __forceinline__ unsigned cvt_pk_bf16(float lo, float hi) { unsigned r; asm volatile("v_cvt_pk_bf16_f32 %0, %1, %2" : "=v"(r) : "v"(lo), "v"(hi)); return r; }
__device__ __forceinline__ float bf_lo(unsigned u) { return __uint_as_float(u << 16); }
__device__ __forceinline__ float bf_hi(unsigned u) { return __uint_as_float(u & 0xffff0000u); }
__device__ __forceinline__ float frcp(float x) { return __builtin_amdgcn_rcpf(x); }
__device__ __forceinline__ float sigmoid_f(float x) { return frcp(1.f + __expf(-x)); }
__device__ __forceinline__ float gelu_tanh_f(float x) { const float u = 0.7978845608028654f * (x + 0.044715f * x * x * x); return x * frcp(1.f + __expf(-2.f * u)); }
template <int M> __device__ __forceinline__ float shx(float v, int lane) {
    if constexpr (M < 32) return __int_as_float(__builtin_amdgcn_ds_swizzle(__float_as_int(v), (M << 10) | 0x1f));
    else return __int_as_float(__builtin_amdgcn_ds_bpermute((lane ^ 32) << 2, __float_as_int(v)));
}
__device__ __forceinline__ float wave_sum(float v, int lane) {
    v += shx<1>(v, lane); v += shx<2>(v, lane); v += shx<4>(v, lane); v += shx<8>(v, lane); v += shx<16>(v, lane); v += shx<32>(v, lane);
    return v;
}
__device__ __forceinline__ int otid() { int t = threadIdx.x; asm volatile("" : "+v"(t)); return t; }
__device__ __forceinline__ int obid() { int b = blockIdx.x; asm volatile("" : "+s"(b)); return b; }
__device__ __forceinline__ int modrow_of_tile(int pm) { return pm < 16 ? 0 : 1 + ((pm - 16) >> 3); }


#define XB_TMO      128
#define XB_XCNT(j)  (256  + 64 * (j))
#define XB_XSUB(j)  (1280 + 64 * (j))
#define XB_XGEN(j)  (2304 + 64 * (j))
#define XB_TOP      3328
#define XB_TOPGEN   3392
#define XCD_BAR_WORDS 3456
#define XB_SPIN_CAP (1u << 18)
__device__ __forceinline__ unsigned xb_ld(unsigned* p)              { return __hip_atomic_load(p, __ATOMIC_RELAXED, __HIP_MEMORY_SCOPE_AGENT); }
__device__ __forceinline__ unsigned xb_add(unsigned* p, unsigned v) { return __hip_atomic_fetch_add(p, v, __ATOMIC_RELAXED, __HIP_MEMORY_SCOPE_AGENT); }
__device__ __forceinline__ unsigned xb_xcc_id() { return (unsigned)__builtin_amdgcn_s_getreg((3 << 11) | 20) & 0xFu; }
#define XB_SPIN(cond, bar) do { unsigned _sp = 0; while (cond) { __builtin_amdgcn_s_sleep(1); \
    if ((++_sp & 255u) == 0u) { if (xb_ld(&(bar)[XB_TMO])) break; if (_sp > XB_SPIN_CAP) { atomicAdd(&(bar)[XB_TMO], 1u); break; } } } } while (0)
struct XcdBarrier { unsigned* bar; unsigned x; volatile LAS unsigned* st; };
__device__ __forceinline__ XcdBarrier xcd_barrier_post(unsigned* bar, volatile LAS unsigned* st) {
    XcdBarrier b; b.bar = bar; b.x = xb_xcc_id(); b.st = st;
    if (threadIdx.x == 0) (void)xb_add(&bar[XB_XCNT(b.x)], 1u);
    return b;
}
__device__ __forceinline__ void xcd_barrier_complete(unsigned* bar, unsigned x, unsigned& nloc, unsigned& nx) {
    const unsigned G = gridDim.x * gridDim.y * gridDim.z;
    unsigned sum, cnt, mine, sp = 0u;
    for (;;) {
        sum = 0u; cnt = 0u; mine = 0u;
#pragma unroll
        for (unsigned j = 0; j < 16; ++j) { const unsigned c = xb_ld(&bar[XB_XCNT(j)]); sum += c; cnt += (c > 0u) ? 1u : 0u; mine = (j == x) ? c : mine; }
        if (sum == G) break;
        __builtin_amdgcn_s_sleep(1);
        if ((++sp & 255u) == 0u) { if (xb_ld(&bar[XB_TMO])) break; if (sp > XB_SPIN_CAP) { atomicAdd(&bar[XB_TMO], 1u); break; } }
    }
    nloc = mine > 0u ? mine : 1u; nx = cnt > 0u ? cnt : 1u;
}
__device__ __forceinline__ void xcd_barrier(const XcdBarrier& b) {
    asm volatile("s_waitcnt vmcnt(0)" ::: "memory");
    __syncthreads();
    if (threadIdx.x == 0) {
        unsigned* bar = b.bar;
        __builtin_amdgcn_s_waitcnt(0);
        unsigned nloc = b.st[0], nx = b.st[1];
        if (nloc == 0u) { xcd_barrier_complete(bar, b.x, nloc, nx); b.st[0] = nloc; b.st[1] = nx; }
        const unsigned old = xb_add(&bar[XB_XSUB(b.x)], 1u);
        const unsigned gen = old / nloc;
        if (old + 1u == (gen + 1u) * nloc) {
            __builtin_amdgcn_fence(__ATOMIC_RELEASE, "agent");
            asm volatile("s_waitcnt vmcnt(0)" ::: "memory");
            const unsigned og = xb_add(&bar[XB_TOP], 1u);
            const unsigned tg = og / nx;
            if (og + 1u == (tg + 1u) * nx) xb_add(&bar[XB_TOPGEN], 1u);
            else XB_SPIN(xb_ld(&bar[XB_TOPGEN]) == tg, bar);
            __builtin_amdgcn_fence(__ATOMIC_ACQUIRE, "agent");
            xb_add(&bar[XB_XGEN(b.x)], 1u);
            asm volatile("s_waitcnt vmcnt(0)" ::: "memory");
        } else {
            XB_SPIN(xb_ld(&bar[XB_XGEN(b.x)]) == gen, bar);
            __builtin_amdgcn_fence(__ATOMIC_ACQUIRE, "agent");
            asm volatile("s_waitcnt vmcnt(0)" ::: "memory");
        }
    }
    __syncthreads();
}

constexpr int BK = 64, HALF = 128, HTB = HALF * BK * 2, STAGE_BYTES = 8 * HTB, NXCD = 8, WGM = 8;
__device__ __forceinline__ int lds_byte(int r, int c) { const int st = (r >> 4) * 2 + (c >> 5), rr = r & 15, cc = c & 31, ob = rr * 64 + cc * 2; return st * 1024 + (ob ^ (((ob >> 9) & 1) << 5)); }
__device__ __forceinline__ void stage_rc(int b, int& R, int& C) { const int st = b / 1024, sb = b % 1024, swz = sb ^ (((sb >> 9) & 1) << 5); R = (st >> 1) * 16 + swz / 64; C = (st & 1) * 32 + (swz % 64) / 2; }
__device__ __forceinline__ int perm32(int rho) { const int n = rho >> 4, i = rho & 15; return 8 * (i >> 2) + 4 * n + (i & 3); }

enum { EK_XR = 0, EK_GY, EK_YT, EK_SG, EK_GATE, EK_DFT_LAT, EK_DFT_CTX, EK_G4A, EK_G4B, EK_RES1, EK_SWIGLU, EK_RES2 };
enum { ST_B = 0, ST_C, ST_D1, ST_D2, ST_S1, ST_S15, ST_S2, ST_G4, ST_G5, ST_K, ST_L, NST, ST_D2C };

struct UnitD { const char* A; const char* B; int nt, kind, rt, ct, aux; };

__device__ __forceinline__ void tile_order(int L, int nM, int nN, int& pm, int& pn) {
    const int nwg = nM * nN;
    int wgid = L;
    { const int q = nwg / NXCD, r = nwg % NXCD, xcd = wgid % NXCD, off = wgid / NXCD; wgid = (xcd < r ? xcd * (q + 1) : r * (q + 1) + (xcd - r) * q) + off; }
    const int nig = WGM * nN, gid = wgid / nig, fm = gid * WGM, gsz = (nM - fm) < WGM ? (nM - fm) : WGM;
    pm = fm + ((wgid % nig) % gsz); pn = (wgid % nig) / gsz;
}

__device__ __forceinline__ bool get_unit(const Params& p, int step, int i, UnitD& u) {
    asm volatile("" : "+s"(step));
    const int G = gridDim.x, c = obid();
    const char* ws = (const char*)p.ws;
    u.aux = 0;
    switch (step) {
    case ST_B: {
        const int L = i * G + c; if (L >= 48 * 20) return false;
        int pm, pn; tile_order(L, 48, 20, pm, pn);
        if (pn >= 8 && pn < 12) { u.A = ws + WS_WIN + (size_t)pn * 256 * 1024 * 2; u.B = ws + WS_H + (size_t)pm * 256 * 1024 * 2; u.kind = EK_YT; u.rt = pn - 8; u.ct = pm; }
        else { u.A = ws + WS_H + (size_t)pm * 256 * 1024 * 2; u.B = ws + WS_WIN + (size_t)pn * 256 * 1024 * 2; u.kind = pn < 4 ? EK_XR : (pn < 8 ? EK_GY : EK_SG); u.rt = pm; u.ct = pn; }
        u.nt = 16; return true; }
    case ST_D1: {
        const int L = i * G + c; if (L >= 48 * 16) return false;
        int pm, pq; tile_order(L, 48, 16, pm, pq);
        const int h = pq >> 2, pn = pq & 3;
        u.A = ws + WS_XC + ((size_t)pm * 256 * 1024 + h * 256) * 2; u.B = ws + WS_WG + ((size_t)(h * 1024 + pn * 256) * 256) * 2;
        u.kind = EK_GATE; u.rt = pm; u.ct = pn; u.aux = h; u.nt = 4; return true; }
    case ST_D2: {
        const int L = i * G + c; if (L >= (G >= 256 ? 256 : 288)) return false;
        if (L < 256) { const int ks = L & 3, pn = (L >> 2) & 1, pm = (L >> 3) & 7, b = L >> 6;
            u.A = ws + WS_DLAT + ((size_t)pm * 256 * 4096 + ks * 1024) * 2;
            u.B = ws + WS_YT + ((size_t)pn * 256 * YLD + 2 * (TCTX + b * 2048) + ks * 1024) * 2;
            u.kind = EK_DFT_LAT; u.rt = pm; u.ct = pn; u.aux = b * 4 + ks; u.nt = 16; }
        else { const int q = L - 256, pn = q & 1, b = q >> 1;
            u.A = ws + WS_DCTX; u.B = ws + WS_YT + ((size_t)pn * 256 * YLD + 2 * (b * 256)) * 2;
            u.kind = EK_DFT_CTX; u.rt = 0; u.ct = pn; u.aux = b; u.nt = 8; }
        return true; }
    case ST_D2C: {
        const int q = c - 224; if (i > 0 || q < 0 || q >= 32) return false;
        const int pn = q & 1, b = q >> 1;
        u.A = ws + WS_DCTX; u.B = ws + WS_YT + ((size_t)pn * 256 * YLD + 2 * (b * 256)) * 2;
        u.kind = EK_DFT_CTX; u.rt = 0; u.ct = pn; u.aux = b; u.nt = 8; return true; }
    case ST_G4: {
        const int L = (i >> 1) * G + c, sub = i & 1; if (L >= 48 * 4) return false;
        int pm, pn; tile_order(L, 48, 4, pm, pn);
        const size_t ko = sub == 0 ? 1024 * 2 : 0;
        u.A = ws + WS_RGFF + (size_t)pm * 256 * 1536 * 2 + ko; u.B = ws + WS_WLOFO + (size_t)pn * 256 * 1536 * 2 + ko;
        u.kind = sub == 0 ? EK_G4A : EK_G4B; u.rt = pm; u.ct = pn; u.nt = sub == 0 ? 8 : 16; return true; }
    case ST_G5: {
        const int L = i * G + c; if (L >= 48 * 4) return false;
        int pm, pn; tile_order(L, 48, 4, pm, pn);
        u.A = ws + WS_XC + (size_t)pm * 256 * 1024 * 2; u.B = ws + WS_WOUT + (size_t)pn * 256 * 1024 * 2;
        u.kind = EK_RES1; u.rt = pm; u.ct = pn; u.nt = 16; return true; }
    case ST_K: {
        const int L = i * G + c; if (L >= 48 * 22) return false;
        int pm, pn; tile_order(L, 48, 22, pm, pn);
        u.A = ws + WS_H + (size_t)pm * 256 * 1024 * 2; u.B = ws + WS_WFFI + (size_t)pn * 256 * 1024 * 2;
        u.kind = EK_SWIGLU; u.rt = pm; u.ct = pn; u.nt = 16; return true; }
    case ST_L: {
        const int L = i * G + c; if (L >= 48 * 4) return false;
        int pm, pn; tile_order(L, 48, 4, pm, pn);
        u.A = ws + WS_BIG + (size_t)pm * 256 * 2816 * 2; u.B = ws + WS_WFFO + (size_t)pn * 256 * 2816 * 2;
        u.kind = EK_RES2; u.rt = pm; u.ct = pn; u.nt = 44; return true; }
    default: return false;
    }
}

constexpr int LDS_RSTD = STAGE_BYTES + 256;
constexpr int LDS_RSSP = STAGE_BYTES + 256 + 1024;
constexpr int LDS_BIASP = LDS_RSSP + 16384;
__device__ __forceinline__ void epi_prefetch(const Params& p, int layer, const UnitD& u, LAS unsigned char* lds, int wid, int lane) {
    const int k = u.kind;
    if (k == EK_RES1 || k == EK_RES2) {
        if (wid < 3) { const int mr = modrow_of_tile(u.rt), nl = k == EK_RES1 ? layer : (layer < 3 ? layer + 1 : layer);
            const float* src = wid == 0 ? (const float*)(p.ws + WS_MOD) + (size_t)((layer * 5 + mr) * 6 + (k == EK_RES1 ? 2 : 5)) * 1024
                             : wid == 1 ? (k == EK_RES1 ? p.norm2_g : p.norm1_g) + nl * 1024
                                        : (const float*)(p.ws + WS_MOD) + (size_t)((nl * 5 + mr) * 6 + (k == EK_RES1 ? 4 : 1)) * 1024;
            unsigned lo2 = (unsigned)lane * 16u; asm volatile("" : "+v"(lo2));
            __builtin_amdgcn_global_load_lds((const unsigned*)((const char*)(src + u.ct * 256) + lo2), (LAS unsigned*)(lds + LDS_BIASP + wid * 1024), 16, 0, 0); }
        return; }
    if (!(k == EK_XR || k == EK_GY || k == EK_SG || k == EK_YT || k == EK_SWIGLU)) return;
    const int tile = k == EK_YT ? u.ct : u.rt;
    const float* rssg = (const float*)(p.ws + WS_RSS) + (size_t)tile * 4096;
    const float* bias = k == EK_SWIGLU ? (const float*)(p.ws + WS_BM2) + modrow_of_tile(tile) * 5632 + u.ct * 256
                      : k == EK_YT     ? (const float*)(p.ws + WS_BM1) + modrow_of_tile(tile) * NIN5 + 2048 + u.rt * 256
                                       : (const float*)(p.ws + WS_BM1) + modrow_of_tile(tile) * NIN5 + u.ct * 256;
    unsigned lo = (unsigned)lane * 16u;
    asm volatile("" : "+v"(lo));
#pragma unroll
    for (int i = 0; i < 2; ++i)
        __builtin_amdgcn_global_load_lds((const unsigned*)((const char*)rssg + (size_t)(i * 8192 + wid * 1024) + lo), (LAS unsigned*)(lds + LDS_RSSP + i * 8192 + wid * 1024), 16, 0, 0);
    if (wid == 0) __builtin_amdgcn_global_load_lds((const unsigned*)((const char*)bias + lo), (LAS unsigned*)(lds + LDS_BIASP), 16, 0, 0);
}
__device__ __forceinline__ const LAS float* rstd_to_lds(LAS unsigned char* lds) {
    LAS float* rs = (LAS float*)(lds + LDS_RSTD);
    const int t = otid();
    if (t < 256) { const LAS f32x4* rp = (const LAS f32x4*)(lds + LDS_RSSP) + t * 4;
        const f32x4 s4 = (rp[0] + rp[1]) + (rp[2] + rp[3]);
        rs[t] = rsqrtf(((s4.x + s4.y) + (s4.z + s4.w)) * (1.f / 1024.f) + 1e-6f); }
    asm volatile("s_waitcnt lgkmcnt(0)" ::: "memory"); __builtin_amdgcn_s_barrier(); asm volatile("" ::: "memory");
    return rs;
}

__device__ __forceinline__ void epilogue(const Params& p, int layer, const UnitD& u, f32x4 (&acc)[2][2][4][2], int wr, int wc, int fr, int fq, LAS unsigned char* lds) {
    unsigned char* ws = p.ws;
    int rl = wr * 64 + fr;
    int cl = wc * 32 + 8 * fq;
    asm volatile("" : "+v"(rl), "+v"(cl));
    switch (u.kind) {
    case EK_XR: case EK_GY: case EK_SG: {
        const LAS float* bias = (const LAS float*)(lds + LDS_BIASP) + cl;
        const LAS float* rsl = rstd_to_lds(lds);
        f32x4 bv[2][2];
#pragma unroll
        for (int bj = 0; bj < 2; ++bj) { bv[bj][0] = *(const LAS f32x4*)(bias + bj * 128); bv[bj][1] = *(const LAS f32x4*)(bias + bj * 128 + 4); }
        bf16_t* base; int ld;
        if (u.kind == EK_XR) { base = (bf16_t*)(ws + WS_XR) + u.ct * 256; ld = 1024; }
        else if (u.kind == EK_GY) { base = (bf16_t*)(ws + WS_GY) + (u.ct - 4) * 256; ld = 1024; }
        else { base = (bf16_t*)(ws + WS_SG) + (u.ct - 12) * 256; ld = 2048; }
#pragma unroll
        for (int ai = 0; ai < 2; ++ai)
#pragma unroll
            for (int m = 0; m < 4; ++m) {
                const int row = u.rt * 256 + rl + ai * 128 + m * 16;
                bf16_t* rowp = base + (size_t)row * ld + cl;
                const float rstd = rsl[rl + ai * 128 + m * 16];
#pragma unroll
                for (int bj = 0; bj < 2; ++bj) {
                    f32x4 v0 = acc[ai][bj][m][0] * rstd + bv[bj][0], v1 = acc[ai][bj][m][1] * rstd + bv[bj][1];
                    if (u.kind == EK_GY) {
#pragma unroll
                        for (int j = 0; j < 4; ++j) { v0[j] = gelu_tanh_f(v0[j]); v1[j] = gelu_tanh_f(v1[j]); }
                    } else if (u.kind == EK_SG) {
#pragma unroll
                        for (int j = 0; j < 4; ++j) { v0[j] = sigmoid_f(v0[j]); v1[j] = sigmoid_f(v1[j]); }
                    }
                    u32x4 w; w.x = cvt_pk_bf16(v0[0], v0[1]); w.y = cvt_pk_bf16(v0[2], v0[3]); w.z = cvt_pk_bf16(v1[0], v1[1]); w.w = cvt_pk_bf16(v1[2], v1[3]);
                    *(u32x4*)(rowp + bj * 128) = w;
                }
            }
        break; }
    case EK_YT: {
        const int tt = u.ct;
        int seqbase, Ls, pos0;
        if (tt < 16) { seqbase = tt * 256; Ls = 256; pos0 = 0; } else { const int s = (tt - 16) >> 3; seqbase = TCTX + s * 2048; Ls = 2048; pos0 = ((tt - 16) & 7) * 256; }
        const LAS float* bias = (const LAS float*)(lds + LDS_BIASP);
        bf16_t* yt = (bf16_t*)(ws + WS_YT);
        const LAS float* rsl = rstd_to_lds(lds);
        f32x4 rs[2][2];
#pragma unroll
        for (int bj = 0; bj < 2; ++bj)
#pragma unroll
            for (int n = 0; n < 2; ++n)
#pragma unroll
                for (int j = 0; j < 4; ++j) rs[bj][n][j] = rsl[cl + bj * 128 + n * 4 + j];
#pragma unroll
        for (int ai = 0; ai < 2; ++ai)
#pragma unroll
            for (int m = 0; m < 4; ++m) {
                const int n = u.rt * 256 + rl + ai * 128 + m * 16;
                const float bb = bias[rl + ai * 128 + m * 16];
                const int part = n >> 9, nn = n & 511;
                bf16_t* rowp = yt + (size_t)nn * YLD + 2 * seqbase + part * Ls + pos0 + cl;
#pragma unroll
                for (int bj = 0; bj < 2; ++bj) {
                    const f32x4 v0 = acc[ai][bj][m][0] * rs[bj][0] + bb, v1 = acc[ai][bj][m][1] * rs[bj][1] + bb;
                    u32x4 w; w.x = cvt_pk_bf16(v0[0], v0[1]); w.y = cvt_pk_bf16(v0[2], v0[3]); w.z = cvt_pk_bf16(v1[0], v1[1]); w.w = cvt_pk_bf16(v1[2], v1[3]);
                    *(u32x4*)(rowp + bj * 128) = w;
                }
            }
        break; }
    case EK_GATE: {
        const int h = u.aux, dir = u.ct >> 1;
        const int e0 = h * 256 + (u.ct & 1) * 128 + cl;
        const int pofs = (layer * 2 + dir) * 1024 + e0;
        f32x4 ba[2], bx[2], sp[2];
#pragma unroll
        for (int n = 0; n < 2; ++n) {
            ba[n] = *(const f32x4*)(p.lru_ba + pofs + 4 * n); bx[n] = *(const f32x4*)(p.lru_bx + pofs + 4 * n);
            sp[n] = *(const f32x4*)((const float*)(ws + WS_SP) + (dir * 1024 + e0) + 4 * n);
        }
        const bf16_t* xc = (const bf16_t*)(ws + WS_XC);
        bf16_t* la = (bf16_t*)(ws + WS_LA) + (size_t)dir * T * 1024;
        bf16_t* bbp = (bf16_t*)(ws + WS_BB) + (size_t)dir * T * 1024;
        u32x4 xall[2][4];
#pragma unroll
        for (int ai = 0; ai < 2; ++ai)
#pragma unroll
            for (int m = 0; m < 4; ++m) xall[ai][m] = *(const u32x4*)(xc + (size_t)(u.rt * 256 + rl + ai * 128 + m * 16) * 1024 + e0);
#pragma unroll
        for (int ai = 0; ai < 2; ++ai)
#pragma unroll
            for (int m = 0; m < 4; ++m) {
                const size_t ro = (size_t)(u.rt * 256 + rl + ai * 128 + m * 16) * 1024 + e0;
                const u32x4 xv = xall[ai][m];
                float xf[8] = {bf_lo(xv.x), bf_hi(xv.x), bf_lo(xv.y), bf_hi(xv.y), bf_lo(xv.z), bf_hi(xv.z), bf_lo(xv.w), bf_hi(xv.w)};
                float lo[8], bo[8];
#pragma unroll
                for (int n = 0; n < 2; ++n)
#pragma unroll
                    for (int j = 0; j < 4; ++j) {
                        const float r = sigmoid_f(acc[ai][0][m][n][j] + ba[n][j]);
                        const float ig = sigmoid_f(acc[ai][1][m][n][j] + bx[n][j]);
                        const float l = r * sp[n][j];
                        const float x2 = 2.f * l;
                        const float ser = -x2 * (1.f + x2 * (0.5f + x2 * (0.16666667f + x2 * 0.041666668f)));
                        const float om = x2 > -0.06f ? ser : 1.f - __expf(x2);
                        const float mult = __builtin_amdgcn_sqrtf(fmaxf(om, 0.f));
                        lo[4 * n + j] = l; bo[4 * n + j] = mult * ig * xf[4 * n + j];
                    }
                u32x4 w; w.x = cvt_pk_bf16(lo[0], lo[1]); w.y = cvt_pk_bf16(lo[2], lo[3]); w.z = cvt_pk_bf16(lo[4], lo[5]); w.w = cvt_pk_bf16(lo[6], lo[7]);
                *(u32x4*)(la + ro) = w;
                w.x = cvt_pk_bf16(bo[0], bo[1]); w.y = cvt_pk_bf16(bo[2], bo[3]); w.z = cvt_pk_bf16(bo[4], bo[5]); w.w = cvt_pk_bf16(bo[6], bo[7]);
                *(u32x4*)(bbp + ro) = w;
            }
        break; }
    case EK_DFT_LAT: case EK_DFT_CTX: {
        bf16_t* base; int ld; float sc;
        if (u.kind == EK_DFT_LAT) { const int b = u.aux >> 2, ks = u.aux & 3; base = (bf16_t*)(ws + WS_FFP) + ((size_t)ks * 8192 + b * 2048 + u.rt * 256) * 512 + u.ct * 256; ld = 512; sc = 0.0027621358640099515f; }
        else { base = (bf16_t*)(ws + WS_RGFF) + (size_t)(u.aux * 256) * 1536 + 1024 + u.ct * 256; ld = 1536; sc = 0.0078125f; }
#pragma unroll
        for (int ai = 0; ai < 2; ++ai)
#pragma unroll
            for (int m = 0; m < 4; ++m) {
                bf16_t* rowp = base + (size_t)(rl + ai * 128 + m * 16) * ld + cl;
#pragma unroll
                for (int bj = 0; bj < 2; ++bj) {
                    const f32x4 v0 = acc[ai][bj][m][0] * sc, v1 = acc[ai][bj][m][1] * sc;
                    u32x4 w; w.x = cvt_pk_bf16(v0[0], v0[1]); w.y = cvt_pk_bf16(v0[2], v0[3]); w.z = cvt_pk_bf16(v1[0], v1[1]); w.w = cvt_pk_bf16(v1[2], v1[3]);
                    *(u32x4*)(rowp + bj * 128) = w;
                }
            }
        break; }
    case EK_G4B: {
        const bf16_t* sg = (const bf16_t*)(ws + WS_SG) + u.ct * 256 + cl;
        bf16_t* mo = (bf16_t*)(ws + WS_XC) + u.ct * 256 + cl;
        u32x4 gall[2][4][2];
#pragma unroll
        for (int ai = 0; ai < 2; ++ai)
#pragma unroll
            for (int m = 0; m < 4; ++m)
#pragma unroll
                for (int bj = 0; bj < 2; ++bj) gall[ai][m][bj] = *(const u32x4*)(sg + (size_t)(u.rt * 256 + rl + ai * 128 + m * 16) * 2048 + bj * 128);
#pragma unroll
        for (int ai = 0; ai < 2; ++ai)
#pragma unroll
            for (int m = 0; m < 4; ++m) {
                const size_t row = (size_t)(u.rt * 256 + rl + ai * 128 + m * 16);
#pragma unroll
                for (int bj = 0; bj < 2; ++bj) {
                    const u32x4 av = gall[ai][m][bj];
                    f32x4 a0 = {bf_lo(av.x), bf_hi(av.x), bf_lo(av.y), bf_hi(av.y)}, a1 = {bf_lo(av.z), bf_hi(av.z), bf_lo(av.w), bf_hi(av.w)};
#pragma unroll
                    for (int j = 0; j < 4; ++j) { a0[j] = fmaxf(a0[j], 1e-30f); a1[j] = fmaxf(a1[j], 1e-30f); }
                    const f32x4 v0 = a0 * acc[ai][bj][m][0], v1 = a1 * acc[ai][bj][m][1];
                    u32x4 w; w.x = cvt_pk_bf16(v0[0], v0[1]); w.y = cvt_pk_bf16(v0[2], v0[3]); w.z = cvt_pk_bf16(v1[0], v1[1]); w.w = cvt_pk_bf16(v1[2], v1[3]);
                    *(u32x4*)(mo + row * 1024 + bj * 128) = w;
                }
            }
        break; }
    case EK_RES1: case EK_RES2: {
        const bool emit = (u.kind == EK_RES1) || (layer < 3);
        const LAS float* colp = (const LAS float*)(lds + LDS_BIASP) + cl;
        char* xb_b = (char*)(ws + WS_XB); char* xg_b = (char*)(ws + WS_H); char* rss_b = (char*)(ws + WS_RSS);
        const unsigned e0 = (unsigned)((u.rt * 256 + rl) * 1024 + u.ct * 256 + cl);
        const unsigned r0 = (unsigned)((u.rt * 256 + rl) * 16 + u.ct * 4 + wc);
#pragma unroll
        for (int ai = 0; ai < 2; ++ai) {
            u32x4 xl[4][2];
#pragma unroll
            for (int m = 0; m < 4; ++m)
#pragma unroll
                for (int bj = 0; bj < 2; ++bj) { const unsigned eo = e0 + (unsigned)((ai * 128 + m * 16) * 1024 + bj * 128);
                    xl[m][bj] = *(const u32x4*)(xb_b + (size_t)eo * 2); }
#pragma unroll
            for (int m = 0; m < 4; ++m) {
                float ss = 0.f;
#pragma unroll
                for (int bj = 0; bj < 2; ++bj) {
                    const unsigned eo = e0 + (unsigned)((ai * 128 + m * 16) * 1024 + bj * 128);
                    const u32x4 xo = xl[m][bj];
                    const f32x4 g0 = *(const LAS f32x4*)(colp + bj * 128), g1 = *(const LAS f32x4*)(colp + bj * 128 + 4);
                    const f32x4 x0 = (f32x4){bf_lo(xo.x), bf_hi(xo.x), bf_lo(xo.y), bf_hi(xo.y)} + g0 * acc[ai][bj][m][0], x1 = (f32x4){bf_lo(xo.z), bf_hi(xo.z), bf_lo(xo.w), bf_hi(xo.w)} + g1 * acc[ai][bj][m][1];
                    { u32x4 w; w.x = cvt_pk_bf16(x0[0], x0[1]); w.y = cvt_pk_bf16(x0[2], x0[3]); w.z = cvt_pk_bf16(x1[0], x1[1]); w.w = cvt_pk_bf16(x1[2], x1[3]);
                      *(u32x4*)(xb_b + (size_t)eo * 2) = w; }
                    ss += ((x0.x * x0.x + x0.y * x0.y) + (x0.z * x0.z + x0.w * x0.w)) + ((x1.x * x1.x + x1.y * x1.y) + (x1.z * x1.z + x1.w * x1.w));
                    if (emit) { const f32x4 s0 = *(const LAS f32x4*)(colp + 256 + bj * 128) * (*(const LAS f32x4*)(colp + 512 + bj * 128) + 1.f), s1 = *(const LAS f32x4*)(colp + 256 + bj * 128 + 4) * (*(const LAS f32x4*)(colp + 512 + bj * 128 + 4) + 1.f);
                        const f32x4 y0 = x0 * s0, y1 = x1 * s1;
                        u32x4 w; w.x = cvt_pk_bf16(y0[0], y0[1]); w.y = cvt_pk_bf16(y0[2], y0[3]); w.z = cvt_pk_bf16(y1[0], y1[1]); w.w = cvt_pk_bf16(y1[2], y1[3]);
                        *(u32x4*)(xg_b + (size_t)eo * 2) = w; }
                }
                ss += shx<16>(ss, fr + 16 * fq); ss += shx<32>(ss, fr + 16 * fq);
                if (fq == 0) *(float*)(rss_b + (size_t)(r0 + (unsigned)((ai * 128 + m * 16) * 16)) * 4) = ss;
            }
        }
        break; }
    case EK_SWIGLU: {
        bf16_t* so = (bf16_t*)(ws + WS_BIG) + u.ct * 128 + cl;
        const LAS float* bias = (const LAS float*)(lds + LDS_BIASP) + cl;
        const LAS float* rsl = rstd_to_lds(lds);
        f32x4 bv[2][2];
#pragma unroll
        for (int bj = 0; bj < 2; ++bj) { bv[bj][0] = *(const LAS f32x4*)(bias + bj * 128); bv[bj][1] = *(const LAS f32x4*)(bias + bj * 128 + 4); }
#pragma unroll
        for (int ai = 0; ai < 2; ++ai)
#pragma unroll
            for (int m = 0; m < 4; ++m) {
                const int row = u.rt * 256 + rl + ai * 128 + m * 16;
                const float rstd = rsl[rl + ai * 128 + m * 16];
                float o[8];
#pragma unroll
                for (int n = 0; n < 2; ++n)
#pragma unroll
                    for (int j = 0; j < 4; ++j) { const float uu = acc[ai][0][m][n][j] * rstd + bv[0][n][j], vv = acc[ai][1][m][n][j] * rstd + bv[1][n][j]; o[4 * n + j] = uu * sigmoid_f(uu) * vv; }
                u32x4 w; w.x = cvt_pk_bf16(o[0], o[1]); w.y = cvt_pk_bf16(o[2], o[3]); w.z = cvt_pk_bf16(o[4], o[5]); w.w = cvt_pk_bf16(o[6], o[7]);
                *(u32x4*)(so + (size_t)row * DFF) = w;
            }
        break; }
    default: break;
    }
}

__device__ __forceinline__ void g4a_rescale(const Params& p, const UnitD& u, f32x4 (&acc)[2][2][4][2], int wr, int wc, int fr, int fq) {
    int rl = wr * 64 + fr, cl = wc * 32 + 8 * fq;
    asm volatile("" : "+v"(rl), "+v"(cl));
    const bf16_t* sg = (const bf16_t*)(p.ws + WS_SG) + u.ct * 256 + cl;
#pragma unroll
    for (int ai = 0; ai < 2; ++ai) {
        u32x4 al[4][2], gl[4][2];
#pragma unroll
        for (int m = 0; m < 4; ++m)
#pragma unroll
            for (int bj = 0; bj < 2; ++bj) { const size_t row = (size_t)(u.rt * 256 + rl + ai * 128 + m * 16);
                al[m][bj] = *(const u32x4*)(sg + row * 2048 + bj * 128); gl[m][bj] = *(const u32x4*)(sg + row * 2048 + 1024 + bj * 128); }
#pragma unroll
        for (int m = 0; m < 4; ++m) {
#pragma unroll
            for (int bj = 0; bj < 2; ++bj) {
                const u32x4 av = al[m][bj];
                const u32x4 gv = gl[m][bj];
                const float a[8] = {bf_lo(av.x), bf_hi(av.x), bf_lo(av.y), bf_hi(av.y), bf_lo(av.z), bf_hi(av.z), bf_lo(av.w), bf_hi(av.w)};
                const float g[8] = {bf_lo(gv.x), bf_hi(gv.x), bf_lo(gv.y), bf_hi(gv.y), bf_lo(gv.z), bf_hi(gv.z), bf_lo(gv.w), bf_hi(gv.w)};
#pragma unroll
                for (int j = 0; j < 4; ++j) { acc[ai][bj][m][0][j] *= g[j] * frcp(fmaxf(a[j], 1e-30f)); acc[ai][bj][m][1][j] *= g[4 + j] * frcp(fmaxf(a[4 + j], 1e-30f)); }
            }
        }
        asm volatile("" ::: "memory");
    }
}

__device__ __forceinline__ void gemm_phase(LAS unsigned char* lds, const Params& p, const int step, const int layer, const int lda, const int ldb) {
    const int tid = otid(), wid = __builtin_amdgcn_readfirstlane(tid >> 6), lane = tid & 63, wr = wid >> 2, wc = wid & 3, fr = lane & 15, fq = lane >> 4;
    unsigned voffA[2], voffB[2];
#pragma unroll
    for (int i = 0; i < 2; ++i) { int R, C; stage_rc(tid * 16 + i * 8192, R, C); const int Rb = (R & ~31) + perm32(R & 31);
        voffA[i] = (unsigned)(R * lda + C) * 2u; voffB[i] = (unsigned)(Rb * ldb + C) * 2u; }
    const size_t kstep = (size_t)(BK * 2);
    const size_t hstepA = (size_t)HALF * lda * 2, hstepB = (size_t)HALF * ldb * 2;
    const unsigned ldsw = (unsigned)wid * 1024u;
    const int aoff = lds_byte(wr * 64 + fr, fq * 8), boff = lds_byte(wc * 32 + fr, fq * 8);
#define G_SA(b, h) (((b) * 2 + (h)) * HTB)
#define G_SB(b, h) ((4 + (b) * 2 + (h)) * HTB)
#define G_STAGE(bufoff, gbase, voff) do { _Pragma("unroll") for (int _i = 0; _i < 2; ++_i) \
        __builtin_amdgcn_global_load_lds((const unsigned*)((const char*)(gbase) + (voff)[_i]), (LAS unsigned*)(lds + (bufoff) + ldsw + _i * 8192), 16, 0, 0); } while (0)
#define G_LDA(dst, b, h) do { _Pragma("unroll") for (int m = 0; m < 4; ++m) _Pragma("unroll") for (int k = 0; k < 2; ++k) dst[m][k] = *(const LAS bf16x8*)(lds + G_SA(b, h) + aoff + m * 2048 + k * 1024); } while (0)
#define G_LDB(dst, b, h) do { _Pragma("unroll") for (int n = 0; n < 2; ++n) _Pragma("unroll") for (int k = 0; k < 2; ++k) dst[n][k] = *(const LAS bf16x8*)(lds + G_SB(b, h) + boff + n * 2048 + k * 1024); } while (0)
#define G_MMA(ai, bj, At, Bt) do { __builtin_amdgcn_s_setprio(1); _Pragma("unroll") for (int m = 0; m < 4; ++m) _Pragma("unroll") for (int n = 0; n < 2; ++n) _Pragma("unroll") for (int k = 0; k < 2; ++k) \
        acc[ai][bj][m][n] = __builtin_amdgcn_mfma_f32_16x16x32_bf16(Bt[n][k], At[m][k], acc[ai][bj][m][n], 0, 0, 0); __builtin_amdgcn_s_setprio(0); } while (0)
#define G_WAIT_V(n) asm volatile("s_waitcnt vmcnt(" #n ")" ::: "memory")
#define G_WAIT_L(n) asm volatile("s_waitcnt lgkmcnt(" #n ")" ::: "memory")
#define G_BAR __builtin_amdgcn_s_barrier()
#define G_SCHED __builtin_amdgcn_sched_barrier(0)
    UnitD cur, nxt; int ui = 0;
    if (!get_unit(p, step, 0, cur)) return;
    f32x4 acc[2][2][4][2];
#pragma unroll
    for (int a = 0; a < 2; ++a)
#pragma unroll
        for (int b = 0; b < 2; ++b)
#pragma unroll
            for (int m = 0; m < 4; ++m)
#pragma unroll
                for (int n = 0; n < 2; ++n) acc[a][b][m][n] = (f32x4){0.f, 0.f, 0.f, 0.f};
    bf16x8 At[4][2], B0[2][2], B1[2][2];
    const char* cA = cur.A; const char* cB = cur.B;
    G_STAGE(G_SB(0, 0), cB, voffB); G_STAGE(G_SB(0, 1), cB + hstepB, voffB); G_STAGE(G_SA(0, 0), cA, voffA); G_STAGE(G_SA(0, 1), cA + hstepA, voffA);
    if (wr == 1) G_BAR;
    G_WAIT_V(2); G_BAR;
    G_STAGE(G_SB(1, 0), cB + kstep, voffB); G_STAGE(G_SA(1, 0), cA + kstep, voffA); G_STAGE(G_SB(1, 1), cB + hstepB + kstep, voffB);
    G_WAIT_V(6); G_BAR;
    for (;;) {
        epi_prefetch(p, layer, cur, lds, wid, lane);
        const bool has_next = get_unit(p, step, ui + 1, nxt);
        const char* nA = has_next ? nxt.A : cA; const char* nB = has_next ? nxt.B : cB;
        const int nt = cur.nt;
        for (int t = 0; t < nt; t += 2) {
            const bool last = (t == nt - 2);
            const char* a1 = cA + (size_t)(t + 1) * kstep;
            const char* a2 = last ? nA : cA + (size_t)(t + 2) * kstep; const char* b2 = last ? nB : cB + (size_t)(t + 2) * kstep;
            const char* a3 = a2 + kstep; const char* b3 = b2 + kstep;
            G_LDB(B0, 0, 0); G_LDB(B1, 0, 1); G_SCHED; G_LDA(At, 0, 0); G_STAGE(G_SA(1, 1), a1 + hstepA, voffA);
            G_WAIT_V(8); G_WAIT_L(0); G_BAR; G_MMA(0, 0, At, B0); G_MMA(0, 1, At, B1); G_BAR; G_SCHED;
            G_LDA(At, 0, 1); G_STAGE(G_SB(0, 0), b2, voffB); G_STAGE(G_SB(0, 1), b2 + hstepB, voffB); G_STAGE(G_SA(0, 0), a2, voffA);
            G_WAIT_V(8); G_WAIT_L(0); G_BAR; G_MMA(1, 0, At, B0); G_MMA(1, 1, At, B1); G_BAR; G_SCHED;
            G_LDB(B0, 1, 0); G_LDB(B1, 1, 1); G_SCHED; G_LDA(At, 1, 0); G_STAGE(G_SA(0, 1), a2 + hstepA, voffA);
            G_WAIT_V(8); G_WAIT_L(0); G_BAR; G_MMA(0, 0, At, B0); G_MMA(0, 1, At, B1); G_BAR; G_SCHED;
            G_LDA(At, 1, 1); G_STAGE(G_SB(1, 0), b3, voffB); G_STAGE(G_SB(1, 1), b3 + hstepB, voffB); G_STAGE(G_SA(1, 0), a3, voffA);
            G_WAIT_V(8); G_WAIT_L(0); G_BAR; G_MMA(1, 0, At, B0); G_MMA(1, 1, At, B1); G_BAR; G_SCHED;
        }
        if (wr == 0) G_BAR;
        if (cur.kind == EK_G4A) g4a_rescale(p, cur, acc, wr, wc, fr, fq);
        else epilogue(p, layer, cur, acc, wr, wc, fr, fq, lds);
        if (!has_next) break;
        if (cur.kind != EK_G4A)
#pragma unroll
        for (int a = 0; a < 2; ++a)
#pragma unroll
            for (int b = 0; b < 2; ++b)
#pragma unroll
                for (int m = 0; m < 4; ++m)
#pragma unroll
                    for (int n = 0; n < 2; ++n) acc[a][b][m][n] = (f32x4){0.f, 0.f, 0.f, 0.f};
        cur = nxt; cA = nA; cB = nB; ++ui;
        if (wr == 1) G_BAR;
        G_BAR;
    }
    G_WAIT_V(0);
    G_BAR;
#undef G_SA
#undef G_SB
#undef G_STAGE
#undef G_LDA
#undef G_LDB
#undef G_MMA
#undef G_WAIT_V
#undef G_WAIT_L
#undef G_BAR
#undef G_SCHED
}

__device__ __forceinline__ void phase_convert_weights(const Params& p, int l, int mask, int rank, int nranks, LAS unsigned char* lds);
__device__ __forceinline__ void phase_mod(const Params& p, int l_lo, int l_hi, int rank, int nranks, LAS unsigned char* lds) {
    const int tid = otid();
    LAS float* sv = (LAS float*)lds;
    LAS float* red = (LAS float*)(lds + 20480);
    __syncthreads();
    for (int i = tid; i < 5 * 1024; i += 512) { const float v = i < 1024 ? p.c_ctx[i] : p.c[i - 1024]; sv[i] = v / (1.f + __expf(-v)); }
    __syncthreads();
    float* mod = (float*)(p.ws + WS_MOD);
    for (int it = l_lo * 192 + rank; it < l_hi * 192; it += nranks) {
        const int l = it / 192, j0 = (it % 192) * 32, col = tid & 31, ks = tid >> 5;
        const float* w = p.ada_w + ((size_t)l * 1024 + ks * 64) * 6144 + j0 + col;
        float a0 = 0.f, a1 = 0.f, a2 = 0.f, a3 = 0.f, a4 = 0.f;
#pragma unroll 16
        for (int k = 0; k < 64; ++k) { const float wv = w[(size_t)k * 6144]; const int kk = ks * 64 + k;
            a0 += sv[kk] * wv; a1 += sv[1024 + kk] * wv; a2 += sv[2048 + kk] * wv; a3 += sv[3072 + kk] * wv; a4 += sv[4096 + kk] * wv; }
        red[(ks * 5 + 0) * 32 + col] = a0; red[(ks * 5 + 1) * 32 + col] = a1; red[(ks * 5 + 2) * 32 + col] = a2; red[(ks * 5 + 3) * 32 + col] = a3; red[(ks * 5 + 4) * 32 + col] = a4;
        __syncthreads();
        if (tid < 160) { const int r = tid >> 5, cc = tid & 31; float s = 0.f;
#pragma unroll
            for (int k2 = 0; k2 < 16; ++k2) s += red[(k2 * 5 + r) * 32 + cc];
            mod[(size_t)(l * 5 + r) * 6144 + j0 + cc] = s + p.ada_b[l * 6144 + j0 + cc]; }
        __syncthreads();
    }
}
__device__ __forceinline__ void phase_prep(const Params& p, LAS unsigned char* lds) {
    const int tid = otid(), G = gridDim.x, c = obid();
    unsigned char* ws = p.ws;
    LAS float* ct = (LAS float*)(lds + 32768);
    if (tid < 256) ct[tid] = cospif((float)tid * (1.f / 128.f));
    __syncthreads();
    { bf16_t* dc = (bf16_t*)(ws + WS_DCTX);
      for (int i = c * 512 + tid; i < 256 * 64; i += G * 512) { const int pp = i >> 6, k0 = (i & 63) * 8; float v[8];
#pragma unroll
          for (int j = 0; j < 8; ++j) { const int k = k0 + j, kk = k & 255; const int ph = (pp * kk) & 255; v[j] = k < 256 ? ct[ph] : -ct[(ph + 192) & 255]; }
          u32x4 w; w.x = cvt_pk_bf16(v[0], v[1]); w.y = cvt_pk_bf16(v[2], v[3]); w.z = cvt_pk_bf16(v[4], v[5]); w.w = cvt_pk_bf16(v[6], v[7]);
          *(u32x4*)(dc + (size_t)pp * 4096 + k0) = w; }
      bf16_t* dl = (bf16_t*)(ws + WS_DLAT);
      for (int i = c * 512 + tid; i < 2048 * 512; i += G * 512) { const int pp = i >> 9, k0 = (i & 511) * 8; const int r1 = pp >> 6, w1 = pp & 63; float v[8];
#pragma unroll
          for (int j = 0; j < 8; ++j) { const int k = k0 + j, part = k >> 11, pos = k & 2047, r = pos >> 6, w = pos & 63; const int ph = ((2 * r * r1 + w * w1) & 63) * 4;
              v[j] = part == 0 ? ct[ph] : -ct[(ph + 192) & 255]; }
          u32x4 w; w.x = cvt_pk_bf16(v[0], v[1]); w.y = cvt_pk_bf16(v[2], v[3]); w.z = cvt_pk_bf16(v[4], v[5]); w.w = cvt_pk_bf16(v[6], v[7]);
          *(u32x4*)(dl + (size_t)pp * 4096 + k0) = w; } }
    phase_convert_weights(p, 0, 31, c, G, lds);
    __syncthreads();
    phase_mod(p, 0, 2, c, G, lds);
}

__device__ __forceinline__ void tr_item(const float* src, int srcld, bf16_t* dst, int dstld, int lane, LAS float* scr) {
#pragma unroll 8
    for (int i = 0; i < 32; ++i) { const int kk = 2 * i + (lane >> 5); scr[kk * 33 + (lane & 31)] = src[(size_t)kk * srcld + (lane & 31)]; }
    asm volatile("s_waitcnt lgkmcnt(0)" ::: "memory");
    const int c8 = lane & 7;
#pragma unroll
    for (int j = 0; j < 4; ++j) { const int n = (lane >> 3) + 8 * j; const LAS float* s = scr + (8 * c8) * 33 + n;
        u32x4 o; o.x = cvt_pk_bf16(s[0], s[33]); o.y = cvt_pk_bf16(s[2 * 33], s[3 * 33]); o.z = cvt_pk_bf16(s[4 * 33], s[5 * 33]); o.w = cvt_pk_bf16(s[6 * 33], s[7 * 33]);
        *(u32x4*)(dst + (size_t)n * dstld + 8 * c8) = o; }
    asm volatile("s_waitcnt lgkmcnt(0)" ::: "memory");
}

__device__ __forceinline__ void phase_convert_weights(const Params& p, int l, int mask, int rank, int nranks, LAS unsigned char* lds) {
    const int tid = otid(), wid = tid >> 6, lane = tid & 63, G = nranks, c = rank;
    unsigned char* ws = p.ws;
    LAS float* scr = (LAS float*)(lds + wid * 8448);
    LAS float* tw = (LAS float*)(lds + 8 * 8448);
    if (tid < 128) { const int j = tid & 63; tw[tid] = tid < 64 ? cospif((float)j * (1.f / 32.f)) : sinpif((float)j * (1.f / 32.f)); }
    __syncthreads();
    constexpr int I1 = 2048, I2 = 512, I3 = 768, I4 = 512, I5 = 2816, I6 = 1408, NIT = I1 + I2 + I3 + I4 + I5 + I6;
    const int gw = c * 8 + wid, NGW = G * 8;
    const int n0s = (mask & 1) ? I1 + I2 : 0, n1s = (mask & 2) ? I3 : 0, n2s = (mask & 4) ? I4 : 0, n3s = (mask & 8) ? I5 : 0, n4s = (mask & 16) ? I6 : 0;
    const int ntot = n0s + n1s + n2s + n3s + n4s;
    for (int q = gw; q < ntot; q += NGW) {
        int r = q;
        if (r < n0s) { }
        else { r -= n0s; if (r < n1s) r += I1 + I2; else { r -= n1s; if (r < n2s) r += I1 + I2 + I3; else { r -= n2s; if (r < n3s) r += I1 + I2 + I3 + I4; else { r -= n3s; r += I1 + I2 + I3 + I4 + I5; } } } }
        if (r < I1) { const int nb = r & 127, kb = r >> 7, k0 = kb * 64; const int n0 = nb < 64 ? nb * 32 : 3072 + (nb - 64) * 32, s0 = nb < 64 ? nb * 32 : 2560 + (nb - 64) * 32;
            tr_item(p.w_in + ((size_t)l * 1024 + k0) * NIN + s0, NIN, (bf16_t*)(ws + WS_WIN) + (size_t)n0 * 1024 + k0, 1024, lane, scr); continue; }
        r -= I1;
        if (r < I2) { const int mat = r >> 5, q = r & 31, kb = q >> 3, nb = q & 7, k0 = kb * 64, e0 = nb * 32; const int gate = mat >> 3, dir = (mat >> 2) & 1, h = mat & 3;
            const float* src = (gate ? p.lru_wx : p.lru_wa) + ((size_t)(((l * 2 + dir) * 4 + h) * 256 + k0)) * 256 + e0;
            const int n0 = 256 * (dir * 2 + (e0 >> 7)) + 128 * gate + (e0 & 127);
            tr_item(src, 256, (bf16_t*)(ws + WS_WG) + ((size_t)(h * 1024 + n0)) * 256 + k0, 256, lane, scr); continue; }
        r -= I2;
        if (r < I3) {
            if (r < 512) { const int kb = r >> 5, nb = r & 31; tr_item(p.w_lru_out + ((size_t)l * 1024 + kb * 64) * 1024 + nb * 32, 1024, (bf16_t*)(ws + WS_WLOFO) + (size_t)(nb * 32) * 1536 + kb * 64, 1536, lane, scr); }
            else { const int q = r - 512, kb = q >> 5, nb = q & 31; tr_item(p.w_fnet_out + ((size_t)l * 512 + kb * 64) * 1024 + nb * 32, 1024, (bf16_t*)(ws + WS_WLOFO) + (size_t)(nb * 32) * 1536 + 1024 + kb * 64, 1536, lane, scr); }
            continue; }
        r -= I3;
        if (r < I4) { const int kb = r >> 5, nb = r & 31; tr_item(p.w_out + ((size_t)l * 1024 + kb * 64) * 1024 + nb * 32, 1024, (bf16_t*)(ws + WS_WOUT) + (size_t)(nb * 32) * 1024 + kb * 64, 1024, lane, scr); continue; }
        r -= I4;
        if (r < I5) { const int kb = r / 176, nb = r % 176, n0 = nb * 32; const int pn = n0 >> 8, bj = (n0 >> 7) & 1, x = n0 & 127; const int s0 = bj * DFF + pn * 128 + x;
            tr_item(p.ffn_w_in + ((size_t)l * 1024 + kb * 64) * (2 * DFF) + s0, 2 * DFF, (bf16_t*)(ws + WS_WFFI) + (size_t)n0 * 1024 + kb * 64, 1024, lane, scr); continue; }
        r -= I5;
        { const int kb = r >> 5, nb = r & 31; tr_item(p.ffn_w_out + ((size_t)l * DFF + kb * 64) * 1024 + nb * 32, 1024, (bf16_t*)(ws + WS_WFFO) + (size_t)(nb * 32) * DFF + kb * 64, DFF, lane, scr); }
    }
    if (!(mask & 1)) return;
    for (int idx = c * 512 + tid; idx < 65536; idx += G * 512) {
        const int k = idx & 1023, rest = idx >> 10, q = rest & 3, part = (rest >> 2) & 1, g = rest >> 3;
        const f32x4* src = (const f32x4*)(p.w_in + ((size_t)l * 1024 + k) * NIN + 2048 + g * 64);
        const LAS float* tb = tw + part * 64;
        float o[16];
#pragma unroll
        for (int j = 0; j < 16; ++j) o[j] = 0.f;
#pragma unroll
        for (int c4 = 0; c4 < 16; ++c4) { const f32x4 wv = src[c4];
#pragma unroll
            for (int e = 0; e < 4; ++e) { const int cc = c4 * 4 + e; const float wvv = wv[e];
#pragma unroll
                for (int j = 0; j < 16; ++j) o[j] += wvv * tb[(cc * (q * 16 + j)) & 63]; } }
        bf16_t* dst = (bf16_t*)(ws + WS_WIN) + (size_t)(2048 + part * 512 + g * 64 + q * 16) * 1024 + k;
#pragma unroll
        for (int j = 0; j < 16; ++j) dst[(size_t)j * 1024] = (bf16_t)(cvt_pk_bf16(o[j], 0.f) & 0xffffu);
    }
    float* bias = (float*)(ws + WS_BIAS);
    for (int n = c * 512 + tid; n < NIN5; n += G * 512) {
        float v;
        if (n < 2048) v = p.b_in[l * NIN + n];
        else if (n >= 3072) v = p.b_in[l * NIN + n - 512];
        else { const int q = n - 2048, part = q >> 9, g = (q >> 6) & 7, cp = q & 63; const float* b = p.b_in + l * NIN + 2048 + g * 64; const LAS float* tb = tw + part * 64; v = 0.f;
            for (int cc = 0; cc < 64; ++cc) v += b[cc] * tb[(cc * cp) & 63]; }
        bias[n] = v;
    }
    float* spt = (float*)(ws + WS_SP);
    for (int n = c * 512 + tid; n < 2048; n += G * 512) spt[n] = -8.f * log1pf(__expf(-p.lru_lambda[l * 2048 + n]));
}

__device__ __forceinline__ void phase_a0(const Params& p) {
    const int tid = otid(), wid = tid >> 6, lane = tid & 63, bid = obid();
    for (int row = bid * 8 + wid; row < T; row += gridDim.x * 8) {
        const float* xsrc = row < TCTX ? p.x_prompt + (size_t)row * 1024 : p.x_sample + (size_t)(row - TCTX) * 1024;
        const f32x4* xr = (const f32x4*)xsrc + lane;
        f32x4 v[4]; float s = 0.f;
#pragma unroll
        for (int j = 0; j < 4; ++j) { v[j] = xr[64 * j]; s += (v[j].x * v[j].x + v[j].y * v[j].y) + (v[j].z * v[j].z + v[j].w * v[j].w); }
        s = wave_sum(s, lane);
        const int mr = row < TCTX ? 0 : 1 + ((row - TCTX) >> 11);
        const float* mod = (const float*)(p.ws + WS_MOD) + (size_t)(mr * 6 + 1) * 1024;
        u32x2* o8 = (u32x2*)((bf16_t*)(p.ws + WS_H) + (size_t)row * 1024) + lane;
#pragma unroll
        for (int j = 0; j < 4; ++j) {
            const f32x4 g = *((const f32x4*)p.norm1_g + lane + 64 * j), sc = *((const f32x4*)mod + lane + 64 * j);
            const f32x4 y = v[j] * g * (sc + 1.f);
            u32x2 w; w.x = cvt_pk_bf16(y.x, y.y); w.y = cvt_pk_bf16(y.z, y.w); o8[64 * j] = w;
            u32x2 wx; wx.x = cvt_pk_bf16(v[j].x, v[j].y); wx.y = cvt_pk_bf16(v[j].z, v[j].w); ((u32x2*)((bf16_t*)(p.ws + WS_XB) + (size_t)row * 1024) + lane)[64 * j] = wx;
        }
        if (lane < 16) ((float*)(p.ws + WS_RSS))[(size_t)row * 16 + lane] = lane == 0 ? s : 0.f;
    }
}
__device__ __forceinline__ void phase_biasmod(const Params& p, const bf16_t* Wt, int nrows, const float* shift0  , const float* bias, float* out, int ldo, int rank, int nranks) {
    const int tid = otid(), wid = tid >> 6, lane = tid & 63, bid = rank;
    float sh[5][16];
#pragma unroll
    for (int r = 0; r < 5; ++r)
#pragma unroll
        for (int q = 0; q < 2; ++q) { const f32x4 a = *(const f32x4*)(shift0 + (size_t)r * 6144 + lane * 16 + q * 8), b = *(const f32x4*)(shift0 + (size_t)r * 6144 + lane * 16 + q * 8 + 4);
            sh[r][q * 8 + 0] = a.x; sh[r][q * 8 + 1] = a.y; sh[r][q * 8 + 2] = a.z; sh[r][q * 8 + 3] = a.w; sh[r][q * 8 + 4] = b.x; sh[r][q * 8 + 5] = b.y; sh[r][q * 8 + 6] = b.z; sh[r][q * 8 + 7] = b.w; }
    for (int n = bid * 8 + wid; n < nrows; n += nranks * 8) {
        const u32x4 w0 = *(const u32x4*)(Wt + (size_t)n * 1024 + lane * 16), w1 = *(const u32x4*)(Wt + (size_t)n * 1024 + lane * 16 + 8);
        const float wf[16] = {bf_lo(w0.x), bf_hi(w0.x), bf_lo(w0.y), bf_hi(w0.y), bf_lo(w0.z), bf_hi(w0.z), bf_lo(w0.w), bf_hi(w0.w),
                              bf_lo(w1.x), bf_hi(w1.x), bf_lo(w1.y), bf_hi(w1.y), bf_lo(w1.z), bf_hi(w1.z), bf_lo(w1.w), bf_hi(w1.w)};
        float a[5];
#pragma unroll
        for (int r = 0; r < 5; ++r) { float s = 0.f;
#pragma unroll
            for (int k = 0; k < 16; ++k) s += sh[r][k] * wf[k];
            a[r] = wave_sum(s, lane); }
        if (lane < 5) { const float v = lane == 0 ? a[0] : lane == 1 ? a[1] : lane == 2 ? a[2] : lane == 3 ? a[3] : a[4]; out[(size_t)lane * ldo + n] = v + (bias ? bias[n] : 0.f); }
    }
}

__device__ __forceinline__ void phase_final(const Params& p) {
    const int tid = otid(), wid = tid >> 6, lane = tid & 63;
    for (int row = obid() * 8 + wid; row < T; row += gridDim.x * 8) {
        f32x4* xr = (f32x4*)(p.out + (size_t)row * 1024) + lane;
        const u32x2* xb = (const u32x2*)((const bf16_t*)(p.ws + WS_XB) + (size_t)row * 1024) + lane;
        f32x4 v[4]; float s = 0.f;
#pragma unroll
        for (int j = 0; j < 4; ++j) { const u32x2 q = xb[64 * j]; v[j] = (f32x4){bf_lo(q.x), bf_hi(q.x), bf_lo(q.y), bf_hi(q.y)}; s += (v[j].x * v[j].x + v[j].y * v[j].y) + (v[j].z * v[j].z + v[j].w * v[j].w); }
        const float rstd = rsqrtf(wave_sum(s, lane) * (1.f / 1024.f) + 1e-6f);
#pragma unroll
        for (int j = 0; j < 4; ++j) { const f32x4 g = *((const f32x4*)p.final_g + lane + 64 * j); xr[64 * j] = v[j] * rstd * g; }
    }
}

__device__ __forceinline__ void phase_conv(const Params& p, int l) {
    const bf16_t* xr = (const bf16_t*)(p.ws + WS_XR); bf16_t* xc = (bf16_t*)(p.ws + WS_XC);
    for (int i = obid() * 512 + otid(); i < T * 128; i += gridDim.x * 512) {
        const int tok = i >> 7, c8 = (i & 127) * 8;
        int pos, Ls; if (tok < TCTX) { pos = tok & 255; Ls = 256; } else { pos = (tok - TCTX) & 2047; Ls = 2048; }
        const f32x4 b0 = *(const f32x4*)(p.conv_b + l * 1024 + c8), b1 = *(const f32x4*)(p.conv_b + l * 1024 + c8 + 4);
        float a[8] = {b0.x, b0.y, b0.z, b0.w, b1.x, b1.y, b1.z, b1.w};
#pragma unroll
        for (int k = 0; k < 4; ++k) { const int pp = pos + k - 2;
            if (pp >= 0 && pp < Ls) { const u32x4 v = *(const u32x4*)(xr + (size_t)(tok + k - 2) * 1024 + c8);
                const f32x4 w0 = *(const f32x4*)(p.conv_w + (l * 4 + k) * 1024 + c8), w1 = *(const f32x4*)(p.conv_w + (l * 4 + k) * 1024 + c8 + 4);
                a[0] += w0.x * bf_lo(v.x); a[1] += w0.y * bf_hi(v.x); a[2] += w0.z * bf_lo(v.y); a[3] += w0.w * bf_hi(v.y);
                a[4] += w1.x * bf_lo(v.z); a[5] += w1.y * bf_hi(v.z); a[6] += w1.z * bf_lo(v.w); a[7] += w1.w * bf_hi(v.w); } }
        u32x4 w; w.x = cvt_pk_bf16(a[0], a[1]); w.y = cvt_pk_bf16(a[2], a[3]); w.z = cvt_pk_bf16(a[4], a[5]); w.w = cvt_pk_bf16(a[6], a[7]);
        *(u32x4*)(xc + (size_t)tok * 1024 + c8) = w;
    }
}

__device__ __forceinline__ void phase_s1(const Params& p, int rank, int nranks) {
    const int tid = otid(), G = nranks;
    unsigned cl[16], cb[16];
    int it = rank;
    if (it < 2 * NCH) { const int dir = it & 1, ci = it >> 1;
        const unsigned* la = (const unsigned*)(p.ws + WS_LA + ((size_t)dir * T + ci * 16) * 1024 * 2) + tid;
        const unsigned* bb = (const unsigned*)(p.ws + WS_BB + ((size_t)dir * T + ci * 16) * 1024 * 2) + tid;
#pragma unroll
        for (int j = 0; j < 16; ++j) { const int jj = dir ? 15 - j : j; cl[j] = la[jj * 512]; cb[j] = bb[jj * 512]; } }
    for (; it < 2 * NCH; it += G) {
        unsigned nl[16], nb[16];
        const int nx = it + G;
        if (nx < 2 * NCH) { const int dir = nx & 1, ci = nx >> 1;
            const unsigned* la = (const unsigned*)(p.ws + WS_LA + ((size_t)dir * T + ci * 16) * 1024 * 2) + tid;
            const unsigned* bb = (const unsigned*)(p.ws + WS_BB + ((size_t)dir * T + ci * 16) * 1024 * 2) + tid;
#pragma unroll
            for (int j = 0; j < 16; ++j) { const int jj = dir ? 15 - j : j; nl[j] = la[jj * 512]; nb[j] = bb[jj * 512]; } }
        const int dir = it & 1, ci = it >> 1;
        float P0 = 1.f, P1 = 1.f, Q0 = 0.f, Q1 = 0.f;
#pragma unroll
        for (int j = 0; j < 16; ++j) { const unsigned l2 = cl[j], b2 = cb[j];
            const float a0 = __expf(bf_lo(l2)), a1 = __expf(bf_hi(l2)); P0 *= a0; P1 *= a1; Q0 = a0 * Q0 + bf_lo(b2); Q1 = a1 * Q1 + bf_hi(b2); }
        f32x4 o = {P0, Q0, P1, Q1};
        *((f32x4*)(p.ws + WS_SUMM) + ((size_t)(dir * NCH + ci) * 1024 + tid * 2) / 2) = o;
        if (nx < 2 * NCH) {
#pragma unroll
            for (int j = 0; j < 16; ++j) { cl[j] = nl[j]; cb[j] = nb[j]; } }
    }
}
__device__ __forceinline__ void phase_s15(const Params& p, int l, int rank, int nranks) {
    for (int idx = rank * 512 + otid(); idx < 40960; idx += nranks * 512) {
        const int ch = idx & 1023, sd = idx >> 10, dir = sd & 1, seq = sd >> 1;
        if (nranks < 0) continue;
        const int first = seq < 16 ? seq * 16 : 256 + (seq - 16) * 128, n = seq < 16 ? 16 : 128;
        float h = seq < 16 ? 0.f : p.state_lru[(size_t)(((seq - 16) * 4 + l) * 2 + dir) * 1024 + ch];
        const f32x2* S = (const f32x2*)(p.ws + WS_SUMM) + (size_t)(dir * NCH) * 1024 + ch;
        float* C = (float*)(p.ws + WS_CARRY) + (size_t)(dir * NCH) * 1024 + ch;
        if (dir == 0) {
#pragma unroll 8
            for (int cc = first; cc < first + n; ++cc) { C[(size_t)cc * 1024] = h; const f32x2 s = S[(size_t)cc * 1024]; h = s.x * h + s.y; }
        } else {
#pragma unroll 8
            for (int cc = first + n - 1; cc >= first; --cc) { C[(size_t)cc * 1024] = h; const f32x2 s = S[(size_t)cc * 1024]; h = s.x * h + s.y; }
        }
        if (seq < 16) p.out[(size_t)T * 1024 + (size_t)((seq * 4 + l) * 2 + dir) * 1024 + ch] = h;
    }
}
__device__ __forceinline__ void phase_s15_ctx(const Params& p, int l, int rank, int nranks) {
    for (int idx = rank * 512 + otid(); idx < 32768; idx += nranks * 512) {
        const int ch = idx & 1023, sd = idx >> 10, dir = sd & 1, seq = sd >> 1, first = seq * 16;
        const f32x2* S = (const f32x2*)(p.ws + WS_SUMM) + (size_t)(dir * NCH + first) * 1024 + ch;
        float* C = (float*)(p.ws + WS_CARRY) + (size_t)(dir * NCH + first) * 1024 + ch;
        f32x2 sm[16];
#pragma unroll
        for (int k = 0; k < 16; ++k) sm[k] = S[(size_t)k * 1024];
        float h = 0.f;
        if (dir == 0) {
#pragma unroll
            for (int k = 0; k < 16; ++k) { C[(size_t)k * 1024] = h; h = sm[k].x * h + sm[k].y; }
        } else {
#pragma unroll
            for (int k = 15; k >= 0; --k) { C[(size_t)k * 1024] = h; h = sm[k].x * h + sm[k].y; }
        }
        p.out[(size_t)T * 1024 + (size_t)((seq * 4 + l) * 2 + dir) * 1024 + ch] = h;
    }
}
__device__ __forceinline__ void phase_s15_lat(const Params& p, int l, int rank, int nranks, LAS unsigned char* lds) {
    const int tid = otid(), g = tid >> 6, cl = tid & 63;
    LAS f32x2* gs = (LAS f32x2*)lds;
    for (int it = rank; it < 128; it += nranks) {
        const int slice = it & 15, dir = (it >> 4) & 1, sq = it >> 5, ch = slice * 64 + cl;
        const int first = 256 + sq * 128;
        const int c0 = dir == 0 ? first + g * 16 : first + 127 - g * 16, cs = dir == 0 ? 1 : -1;
        const f32x2* S = (const f32x2*)(p.ws + WS_SUMM) + (size_t)(dir * NCH) * 1024 + ch;
        float* C = (float*)(p.ws + WS_CARRY) + (size_t)(dir * NCH) * 1024 + ch;
        f32x2 sm[16];
#pragma unroll
        for (int k = 0; k < 16; ++k) sm[k] = S[(size_t)(c0 + cs * k) * 1024];
        float P = 1.f, Q = 0.f;
#pragma unroll
        for (int k = 0; k < 16; ++k) { P *= sm[k].x; Q = sm[k].x * Q + sm[k].y; }
        __syncthreads();
        gs[g * 64 + cl] = (f32x2){P, Q};
        __syncthreads();
        float h = p.state_lru[(size_t)((sq * 4 + l) * 2 + dir) * 1024 + ch];
        for (int gg = 0; gg < g; ++gg) { const f32x2 s = gs[gg * 64 + cl]; h = s.x * h + s.y; }
#pragma unroll
        for (int k = 0; k < 16; ++k) { C[(size_t)(c0 + cs * k) * 1024] = h; h = sm[k].x * h + sm[k].y; }
    }
}
__device__ __forceinline__ void phase_s2(const Params& p) {
    const int tid = otid(), G = gridDim.x;
    unsigned cF[16], cG[16]; f32x2 cf, cb;
    int ci = obid();
    if (ci < NCH) { const size_t t0 = (size_t)ci * 16;
        const unsigned* laF = (const unsigned*)(p.ws + WS_LA + t0 * 1024 * 2) + tid; const unsigned* bbF = (const unsigned*)(p.ws + WS_BB + t0 * 1024 * 2) + tid;
        cf = *((const f32x2*)((const float*)(p.ws + WS_CARRY) + (size_t)ci * 1024) + tid); cb = *((const f32x2*)((const float*)(p.ws + WS_CARRY) + (size_t)(NCH + ci) * 1024) + tid);
#pragma unroll
        for (int j = 0; j < 16; ++j) { cF[j] = laF[j * 512]; cG[j] = bbF[j * 512]; } }
    for (; ci < NCH; ci += G) {
        const size_t tok0 = (size_t)ci * 16;
        const unsigned* laB = (const unsigned*)(p.ws + WS_LA + ((size_t)T + tok0) * 1024 * 2) + tid;
        const unsigned* bbB = (const unsigned*)(p.ws + WS_BB + ((size_t)T + tok0) * 1024 * 2) + tid;
        const unsigned* gy = (const unsigned*)(p.ws + WS_GY + tok0 * 1024 * 2) + tid;
        unsigned* rg = (unsigned*)(p.ws + WS_RGFF + tok0 * 1536 * 2) + tid;
        unsigned cH[16], cI[16], cY[16];
#pragma unroll
        for (int j = 0; j < 16; ++j) { cH[j] = laB[j * 512]; cI[j] = bbB[j * 512]; cY[j] = gy[j * 512]; }
        float h0 = cf.x, h1 = cf.y; float hf0[16], hf1[16];
#pragma unroll
        for (int j = 0; j < 16; ++j) { const unsigned l2 = cF[j], b2 = cG[j];
            h0 = __expf(bf_lo(l2)) * h0 + bf_lo(b2); h1 = __expf(bf_hi(l2)) * h1 + bf_hi(b2); hf0[j] = h0; hf1[j] = h1; }
        const f32x2 cbk = cb;
        const int nx = ci + G;
        if (nx < NCH) { const size_t t0 = (size_t)nx * 16;
            const unsigned* laF = (const unsigned*)(p.ws + WS_LA + t0 * 1024 * 2) + tid; const unsigned* bbF = (const unsigned*)(p.ws + WS_BB + t0 * 1024 * 2) + tid;
            cf = *((const f32x2*)((const float*)(p.ws + WS_CARRY) + (size_t)nx * 1024) + tid); cb = *((const f32x2*)((const float*)(p.ws + WS_CARRY) + (size_t)(NCH + nx) * 1024) + tid);
#pragma unroll
            for (int j = 0; j < 16; ++j) { cF[j] = laF[j * 512]; cG[j] = bbF[j * 512]; } }
        h0 = cbk.x; h1 = cbk.y;
#pragma unroll
        for (int j = 15; j >= 0; --j) { const unsigned l2 = cH[j], b2 = cI[j], g2 = cY[j];
            h0 = __expf(bf_lo(l2)) * h0 + bf_lo(b2); h1 = __expf(bf_hi(l2)) * h1 + bf_hi(b2);
            rg[j * 768] = cvt_pk_bf16((hf0[j] + h0) * bf_lo(g2), (hf1[j] + h1) * bf_hi(g2)); }
    }
    const bf16_t* ffp = (const bf16_t*)(p.ws + WS_FFP);
    bf16_t* ff = (bf16_t*)(p.ws + WS_RGFF);
#pragma unroll 4
    for (int i = obid() * 512 + tid; i < 8192 * 64; i += gridDim.x * 512) {
        const int tok = i >> 6, c8 = (i & 63) * 8;
        float a[8] = {0.f, 0.f, 0.f, 0.f, 0.f, 0.f, 0.f, 0.f};
#pragma unroll
        for (int s = 0; s < 4; ++s) { const u32x4 v = *(const u32x4*)(ffp + ((size_t)s * 8192 + tok) * 512 + c8);
            a[0] += bf_lo(v.x); a[1] += bf_hi(v.x); a[2] += bf_lo(v.y); a[3] += bf_hi(v.y); a[4] += bf_lo(v.z); a[5] += bf_hi(v.z); a[6] += bf_lo(v.w); a[7] += bf_hi(v.w); }
        u32x4 w; w.x = cvt_pk_bf16(a[0], a[1]); w.y = cvt_pk_bf16(a[2], a[3]); w.z = cvt_pk_bf16(a[4], a[5]); w.w = cvt_pk_bf16(a[6], a[7]);
        *(u32x4*)(ff + (size_t)(TCTX + tok) * 1536 + 1024 + c8) = w;
    }
}

__device__ __forceinline__ void side_job(const Params& p, int j, int l, int rank, int nranks, LAS unsigned char* lds) {
    if (j == ST_K) {
        if (l > 0) phase_convert_weights(p, l, 16, rank, nranks, lds);
        if (l < 3) { __syncthreads(); phase_convert_weights(p, l + 1, 1 | 2 | 4, rank, nranks, lds); }
    } else if (j == ST_G4) {
        if (l > 0) phase_biasmod(p, (const bf16_t*)(p.ws + WS_WFFI), 5632, (const float*)(p.ws + WS_MOD) + (size_t)(l * 5 * 6 + 3) * 1024, nullptr, (float*)(p.ws + WS_BM2), 5632, rank, nranks);
    } else if (j == ST_G5) {
        if (l < 2) phase_mod(p, l + 2, l + 3, rank, nranks, lds);
    } else if (j == ST_L) {
        if (l < 3) { phase_convert_weights(p, l + 1, 8, rank, nranks, lds);
            phase_biasmod(p, (const bf16_t*)(p.ws + WS_WIN), NIN5, (const float*)(p.ws + WS_MOD) + (size_t)((l + 1) * 5 * 6) * 1024, (const float*)(p.ws + WS_BIAS), (float*)(p.ws + WS_BM1), NIN5, rank, nranks); }
    }
    __syncthreads();
}

constexpr int N_STEPS = 3 + 4 * NST;
constexpr int LDS_BYTES = STAGE_BYTES + 256 + 1024 + 16384 + 3072;
__global__ void __launch_bounds__(512, 2) fwd_kernel(Params p) {
    extern __shared__ __attribute__((aligned(16))) unsigned char shm[];
    LAS unsigned char* lds = (LAS unsigned char*)shm;
    volatile LAS unsigned* xst = (volatile LAS unsigned*)(lds + STAGE_BYTES);
    if (threadIdx.x == 0) { xst[0] = 0u; xst[1] = 0u; xst[2] = 0u; xst[3] = 0u; }
    __syncthreads();
    const XcdBarrier xb = xcd_barrier_post((unsigned*)(p.ws + WS_CTL), xst);
    for (int s = p.st_lo; s < p.st_hi; ++s) {
        if (s == 0) phase_prep(p, lds);
        else if (s == 1) { phase_a0(p);
            phase_biasmod(p, (const bf16_t*)(p.ws + WS_WIN), NIN5, (const float*)(p.ws + WS_MOD), (const float*)(p.ws + WS_BIAS), (float*)(p.ws + WS_BM1), NIN5, obid(), gridDim.x);
            phase_biasmod(p, (const bf16_t*)(p.ws + WS_WFFI), 5632, (const float*)(p.ws + WS_MOD) + (size_t)3 * 1024, nullptr, (float*)(p.ws + WS_BM2), 5632, obid(), gridDim.x); }
        else if (s == N_STEPS - 1) phase_final(p);
        else {
            const int l = (s - 2) / NST, j = (s - 2) % NST;
            int lda = 0, ldb = 0, gstep = j;
            switch (j) {
            case ST_C: phase_conv(p, l); break;
            case ST_S1:
                if (gridDim.x >= 256) { const int b = obid();
                    if (b < 224) phase_s1(p, b, 224);
                    else { lda = 4096; ldb = YLD; gstep = ST_D2C; } }
                else phase_s1(p, obid(), (int)gridDim.x);
                break;
            case ST_S15:
                if (gridDim.x >= 224) { const int b = obid();
                    if (b < 128) phase_s15_lat(p, l, b, 128, lds);
                    else if (b < 192) phase_s15_ctx(p, l, b - 128, 64);
                    __syncthreads(); }
                else phase_s15(p, l, obid(), (int)gridDim.x);
                break;
            case ST_S2: phase_s2(p); break;
            case ST_B: case ST_G5: case ST_K: lda = 1024; ldb = 1024; break;
            case ST_D1: lda = 1024; ldb = 256; break;
            case ST_D2: lda = 4096; ldb = YLD; break;
            case ST_G4: lda = 1536; ldb = 1536; break;
            case ST_L: lda = DFF; ldb = DFF; break;
            default: break;
            }
            if (lda) {
                const bool has_side = (j == ST_G4 || j == ST_G5 || j == ST_L);
                const int G = gridDim.x, lo = (j == ST_K) ? 32 : 192;
                const bool idle = G > 192 && obid() >= lo;
                if ((has_side || j == ST_K) && (idle || G <= 192)) side_job(p, j, l, idle ? obid() - lo : obid(), idle ? G - lo : G, lds);
                if (!(has_side && idle)) { gemm_phase(lds, p, gstep, l, lda, ldb); __syncthreads(); }
            }
            if (j == ST_D1 && s + 1 < p.st_hi) continue;
        }
#if COOP
        if (s + 1 < p.st_hi) {
            if (s == 0) cg::this_grid().sync();
            else xcd_barrier(xb);
        }
#endif
    }
}

extern "C" void kernel_launch(void* const* d_in, const int* in_sizes, int n_in, void* d_out, int out_size, void* d_ws, size_t ws_size, hipStream_t stream) {
    static int grid = 0;
    if (grid == 0) {
        if (n_in != 24 || ws_size < WS_END) { fprintf(stderr, "kernel_launch: unexpected n_in %d or workspace %zu < %zu\n", n_in, ws_size, (size_t)WS_END); grid = -1; return; }
        int dev = 0, cus = 0, per_cu = 0;
        hipGetDevice(&dev);
        hipDeviceGetAttribute(&cus, hipDeviceAttributeMultiprocessorCount, dev);
        if (hipFuncSetAttribute((const void*)fwd_kernel, hipFuncAttributeMaxDynamicSharedMemorySize, LDS_BYTES) != hipSuccess) { fprintf(stderr, "hipFuncSetAttribute failed\n"); grid = -1; return; }
        hipOccupancyMaxActiveBlocksPerMultiprocessor(&per_cu, (const void*)fwd_kernel, 512, LDS_BYTES);
        if (per_cu < 1) { fprintf(stderr, "occupancy query says %d blocks per CU\n", per_cu); per_cu = 1; }
        (void)hipGetLastError();
        grid = cus * 1;
    }
    if (grid < 0) return;
    if (hipMemsetAsync((char*)d_ws + WS_CTL, 0, XCD_BAR_WORDS * 4, stream) != hipSuccess) { fprintf(stderr, "memset failed\n"); return; }
    Params p{};
    const float** f = (const float**)&p;
    for (int i = 0; i < 24; ++i) f[i] = (const float*)d_in[i];
    p.out = (float*)d_out; p.ws = (unsigned char*)d_ws;
#if COOP
    p.st_lo = 0; p.st_hi = N_STEPS;
    void* args[] = {&p};
    hipError_t e = hipLaunchCooperativeKernel((const void*)fwd_kernel, dim3(grid), dim3(512), args, LDS_BYTES, stream);
    if (e != hipSuccess) fprintf(stderr, "cooperative launch failed: %s (grid %d)\n", hipGetErrorString(e), grid);
#else
    for (int s = 0; s < N_STEPS; ++s) {
        p.st_lo = s; p.st_hi = s + 1;
        hipLaunchKernelGGL(fwd_kernel, dim3(grid), dim3(512), LDS_BYTES, stream, p);
    }
#endif
}
```

```cpp
#include <hip/hip_runtime.h>
#include <hip/hip_cooperative_groups.h>
#include <cstdio>
#include <cstdint>
namespace cg = cooperative_groups;

#ifndef COOP
#define COOP 1
#endif
#ifndef REP_MASK
#define REP_MASK 0
#endif
#ifndef SYNC_REP
#define SYNC_REP 1
#endif

#define LAS __attribute__((address_space(3)))
typedef unsigned short bf16_t;
typedef short bf16x8 __attribute__((ext_vector_type(8)));
typedef float f32x4 __attribute__((ext_vector_type(4)));
typedef float f32x2 __attribute__((ext_vector_type(2)));
typedef unsigned u32x4 __attribute__((ext_vector_type(4)));
typedef unsigned u32x2 __attribute__((ext_vector_type(2)));

constexpr int T = 12288, TCTX = 4096, D = 1024, NIN = 4608, NIN5 = 5120, DFF = 2816;
constexpr int NCH = 768;
constexpr int YLD = 2 * T;

constexpr size_t AL(size_t x) { return (x + 255) & ~(size_t)255; }
constexpr size_t WS_CTL = 0;
constexpr size_t WS_MOD = 16384;
constexpr size_t WS_BIAS = AL(WS_MOD + 4 * 5 * 6144 * 4);
constexpr size_t WS_SP = AL(WS_BIAS + NIN5 * 4);
constexpr size_t WS_DCTX = AL(WS_SP + 2 * 1024 * 4);
constexpr size_t WS_DLAT = AL(WS_DCTX + 256 * 4096 * 2);
constexpr size_t WS_WIN = AL(WS_DLAT + (size_t)2048 * 4096 * 2);
constexpr size_t WS_WG = AL(WS_WIN + (size_t)NIN5 * 1024 * 2);
constexpr size_t WS_WLOFO = AL(WS_WG + (size_t)4 * 1024 * 256 * 2);
constexpr size_t WS_WOUT = AL(WS_WLOFO + (size_t)1024 * 1536 * 2);
constexpr size_t WS_WFFI = AL(WS_WOUT + (size_t)1024 * 1024 * 2);
constexpr size_t WS_WFFO = AL(WS_WFFI + (size_t)5632 * 1024 * 2);
constexpr size_t WS_H = AL(WS_WFFO + (size_t)1024 * 2816 * 2);
constexpr size_t WS_XR = AL(WS_H + (size_t)T * 1024 * 2);
constexpr size_t WS_FFP = WS_H;
constexpr size_t WS_GY = AL(WS_XR + (size_t)T * 1024 * 2);
constexpr size_t WS_YT = AL(WS_GY + (size_t)T * 1024 * 2);
constexpr size_t WS_SG = AL(WS_YT + (size_t)512 * YLD * 2);
constexpr size_t WS_XC = AL(WS_SG + (size_t)T * 2048 * 2);
constexpr size_t WS_RGFF = AL(WS_XC + (size_t)T * 1024 * 2);
constexpr size_t WS_BIG = AL(WS_RGFF + (size_t)T * 1536 * 2);
constexpr size_t WS_LA = WS_BIG;
constexpr size_t WS_BB = WS_BIG + (size_t)2 * T * 1024 * 2;
constexpr size_t WS_SUMM = AL(WS_BIG + (size_t)4 * T * 1024 * 2);
constexpr size_t WS_CARRY = AL(WS_SUMM + (size_t)2 * NCH * 1024 * 8);
constexpr size_t WS_BM1 = AL(WS_CARRY + (size_t)2 * NCH * 1024 * 4);
constexpr size_t WS_BM2 = AL(WS_BM1 + (size_t)5 * NIN5 * 4);
constexpr size_t WS_RSS = AL(WS_BM2 + (size_t)5 * 5632 * 4);
constexpr size_t WS_XB = AL(WS_RSS + (size_t)T * 16 * 4);
constexpr size_t WS_END = AL(WS_XB + (size_t)T * 1024 * 2);

struct Params {
    const float *x_prompt, *x_sample, *state_lru, *c, *c_ctx, *norm1_g, *norm2_g, *ada_w, *ada_b, *w_in, *b_in, *conv_w, *conv_b, *lru_wa, *lru_ba, *lru_wx,
        *lru_bx, *lru_lambda, *w_lru_out, *w_fnet_out, *w_out, *ffn_w_in, *ffn_w_out, *final_g;
    float* out;
    unsigned char* ws;
    int st_lo, st_hi;
    int pad0, pad1;
};

__device__ __forceinline__ unsigned cvt_pk_bf16(float lo, float hi) { unsigned r; asm volatile("v_cvt_pk_bf16_f32 %0, %1, %2" : "=v"(r) : "v"(lo), "v"(hi)); return r; }
__device__ __forceinline__ float bf_lo(unsigned u) { return __uint_as_float(u << 16); }
__device__ __forceinline__ float bf_hi(unsigned u) { return __uint_as_float(u & 0xffff0000u); }
__device__ __forceinline__ float frcp(float x) { return __builtin_amdgcn_rcpf(x); }
__device__ __forceinline__ float sigmoid_f(float x) { return frcp(1.f + __expf(-x)); }
__device__ __forceinline__ float gelu_tanh_f(float x) { const float u = 0.7978845608028654f * (x + 0.044715f * x * x * x); return x * frcp(1.f + __expf(-2.f * u)); }
template <int M> __device__ __forceinline__ float shx(float v, int lane) {
    if constexpr (M < 32) return __int_as_float(__builtin_amdgcn_ds_swizzle(__float_as_int(v), (M << 10) | 0x1f));
    else return __int_as_float(__builtin_amdgcn_ds_bpermute((lane ^ 32) << 2, __float_as_int(v)));
}
__device__ __forceinline__ float wave_sum(float v, int lane) {
    v += shx<1>(v, lane); v += shx<2>(v, lane); v += shx<4>(v, lane); v += shx<8>(v, lane); v += shx<16>(v, lane); v += shx<32>(v, lane);
    return v;
}
__device__ __forceinline__ int otid() { int t = threadIdx.x; asm volatile("" : "+v"(t)); return t; }
__device__ __forceinline__ int obid() { int b = blockIdx.x; asm volatile("" : "+s"(b)); return b; }
__device__ __forceinline__ int modrow_of_tile(int pm) { return pm < 16 ? 0 : 1 + ((pm - 16) >> 3); }


#define XB_TMO      128
#define XB_XCNT(j)  (256  + 64 * (j))
#define XB_XSUB(j)  (1280 + 64 * (j))
#define XB_XGEN(j)  (2304 + 64 * (j))
#define XB_TOP      3328
#define XB_TOPGEN   3392
#define XCD_BAR_WORDS 3456
#define XB_SPIN_CAP (1u << 18)
__device__ __forceinline__ unsigned xb_ld(unsigned* p)              { return __hip_atomic_load(p, __ATOMIC_RELAXED, __HIP_MEMORY_SCOPE_AGENT); }
__device__ __forceinline__ unsigned xb_add(unsigned* p, unsigned v) { return __hip_atomic_fetch_add(p, v, __ATOMIC_RELAXED, __HIP_MEMORY_SCOPE_AGENT); }
__device__ __forceinline__ unsigned xb_xcc_id() { return (unsigned)__builtin_amdgcn_s_getreg((3 << 11) | 20) & 0xFu; }
#define XB_SPIN(cond, bar) do { unsigned _sp = 0; while (cond) { __builtin_amdgcn_s_sleep(1); \
    if ((++_sp & 255u) == 0u) { if (xb_ld(&(bar)[XB_TMO])) break; if (_sp > XB_SPIN_CAP) { atomicAdd(&(bar)[XB_TMO], 1u); break; } } } } while (0)
struct XcdBarrier { unsigned* bar; unsigned x; volatile LAS unsigned* st; };
__device__ __forceinline__ XcdBarrier xcd_barrier_post(unsigned* bar, volatile LAS unsigned* st) {
    XcdBarrier b; b.bar = bar; b.x = xb_xcc_id(); b.st = st;
    if (threadIdx.x == 0) (void)xb_add(&bar[XB_XCNT(b.x)], 1u);
    return b;
}
__device__ __forceinline__ void xcd_barrier_complete(unsigned* bar, unsigned x, unsigned& nloc, unsigned& nx) {
    const unsigned G = gridDim.x * gridDim.y * gridDim.z;
    unsigned sum, cnt, mine, sp = 0u;
    for (;;) {
        sum = 0u; cnt = 0u; mine = 0u;
#pragma unroll
        for (unsigned j = 0; j < 16; ++j) { const unsigned c = xb_ld(&bar[XB_XCNT(j)]); sum += c; cnt += (c > 0u) ? 1u : 0u; mine = (j == x) ? c : mine; }
        if (sum == G) break;
        __builtin_amdgcn_s_sleep(1);
        if ((++sp & 255u) == 0u) { if (xb_ld(&bar[XB_TMO])) break; if (sp > XB_SPIN_CAP) { atomicAdd(&bar[XB_TMO], 1u); break; } }
    }
    nloc = mine > 0u ? mine : 1u; nx = cnt > 0u ? cnt : 1u;
}
__device__ __forceinline__ void xcd_barrier(const XcdBarrier& b) {
    asm volatile("s_waitcnt vmcnt(0)" ::: "memory");
    __syncthreads();
    if (threadIdx.x == 0) {
        unsigned* bar = b.bar;
        __builtin_amdgcn_s_waitcnt(0);
        unsigned nloc = b.st[0], nx = b.st[1];
        if (nloc == 0u) { xcd_barrier_complete(bar, b.x, nloc, nx); b.st[0] = nloc; b.st[1] = nx; }
        const unsigned old = xb_add(&bar[XB_XSUB(b.x)], 1u);
        const unsigned gen = old / nloc;
        if (old + 1u == (gen + 1u) * nloc) {
            __builtin_amdgcn_fence(__ATOMIC_RELEASE, "agent");
            asm volatile("s_waitcnt vmcnt(0)" ::: "memory");
            const unsigned og = xb_add(&bar[XB_TOP], 1u);
            const unsigned tg = og / nx;
            if (og + 1u == (tg + 1u) * nx) xb_add(&bar[XB_TOPGEN], 1u);
            else XB_SPIN(xb_ld(&bar[XB_TOPGEN]) == tg, bar);
            __builtin_amdgcn_fence(__ATOMIC_ACQUIRE, "agent");
            xb_add(&bar[XB_XGEN(b.x)], 1u);
            asm volatile("s_waitcnt vmcnt(0)" ::: "memory");
        } else {
            XB_SPIN(xb_ld(&bar[XB_XGEN(b.x)]) == gen, bar);
            __builtin_amdgcn_fence(__ATOMIC_ACQUIRE, "agent");
            asm volatile("s_waitcnt vmcnt(0)" ::: "memory");
        }
    }
    __syncthreads();
}

constexpr int BK = 64, HALF = 128, HTB = HALF * BK * 2, STAGE_BYTES = 8 * HTB, NXCD = 8, WGM = 8;
__device__ __forceinline__ int lds_byte(int r, int c) { const int st = (r >> 4) * 2 + (c >> 5), rr = r & 15, cc = c & 31, ob = rr * 64 + cc * 2; return st * 1024 + (ob ^ (((ob >> 9) & 1) << 5)); }
__device__ __forceinline__ void stage_rc(int b, int& R, int& C) { const int st = b / 1024, sb = b % 1024, swz = sb ^ (((sb >> 9) & 1) << 5); R = (st >> 1) * 16 + swz / 64; C = (st & 1) * 32 + (swz % 64) / 2; }
__device__ __forceinline__ int perm32(int rho) { const int n = rho >> 4, i = rho & 15; return 8 * (i >> 2) + 4 * n + (i & 3); }

enum { EK_XR = 0, EK_GY, EK_YT, EK_SG, EK_GATE, EK_DFT_LAT, EK_DFT_CTX, EK_G4A, EK_G4B, EK_RES1, EK_SWIGLU, EK_RES2 };
enum { ST_B = 0, ST_C, ST_D1, ST_D2, ST_S1, ST_S15, ST_S2, ST_G4, ST_G5, ST_K, ST_L, NST, ST_D2C };

struct UnitD { const char* A; const char* B; int nt, kind, rt, ct, aux; };

__device__ __forceinline__ void tile_order(int L, int nM, int nN, int& pm, int& pn) {
    const int nwg = nM * nN;
    int wgid = L;
    { const int q = nwg / NXCD, r = nwg % NXCD, xcd = wgid % NXCD, off = wgid / NXCD; wgid = (xcd < r ? xcd * (q + 1) : r * (q + 1) + (xcd - r) * q) + off; }
    const int nig = WGM * nN, gid = wgid / nig, fm = gid * WGM, gsz = (nM - fm) < WGM ? (nM - fm) : WGM;
    pm = fm + ((wgid % nig) % gsz); pn = (wgid % nig) / gsz;
}

__device__ __forceinline__ bool get_unit(const Params& p, int step, int i, UnitD& u) {
    asm volatile("" : "+s"(step));
    const int G = gridDim.x, c = obid();
    const char* ws = (const char*)p.ws;
    u.aux = 0;
    switch (step) {
    case ST_B: {
        const int L = i * G + c; if (L >= 48 * 20) return false;
        int pm, pn; tile_order(L, 48, 20, pm, pn);
        if (pn >= 8 && pn < 12) { u.A = ws + WS_WIN + (size_t)pn * 256 * 1024 * 2; u.B = ws + WS_H + (size_t)pm * 256 * 1024 * 2; u.kind = EK_YT; u.rt = pn - 8; u.ct = pm; }
        else { u.A = ws + WS_H + (size_t)pm * 256 * 1024 * 2; u.B = ws + WS_WIN + (size_t)pn * 256 * 1024 * 2; u.kind = pn < 4 ? EK_XR : (pn < 8 ? EK_GY : EK_SG); u.rt = pm; u.ct = pn; }
        u.nt = 16; return true; }
    case ST_D1: {
        const int L = i * G + c; if (L >= 48 * 16) return false;
        int pm, pq; tile_order(L, 48, 16, pm, pq);
        const int h = pq >> 2, pn = pq & 3;
        u.A = ws + WS_XC + ((size_t)pm * 256 * 1024 + h * 256) * 2; u.B = ws + WS_WG + ((size_t)(h * 1024 + pn * 256) * 256) * 2;
        u.kind = EK_GATE; u.rt = pm; u.ct = pn; u.aux = h; u.nt = 4; return true; }
    case ST_D2: {
        const int L = i * G + c; if (L >= (G >= 224 ? 256 : 288)) return false;
        if (L < 256) { const int ks = L & 3, pn = (L >> 2) & 1, pm = (L >> 3) & 7, b = L >> 6;
            u.A = ws + WS_DLAT + ((size_t)pm * 256 * 4096 + ks * 1024) * 2;
            u.B = ws + WS_YT + ((size_t)pn * 256 * YLD + 2 * (TCTX + b * 2048) + ks * 1024) * 2;
            u.kind = EK_DFT_LAT; u.rt = pm; u.ct = pn; u.aux = b * 4 + ks; u.nt = 16; }
        else { const int q = L - 256, pn = q & 1, b = q >> 1;
            u.A = ws + WS_DCTX; u.B = ws + WS_YT + ((size_t)pn * 256 * YLD + 2 * (b * 256)) * 2;
            u.kind = EK_DFT_CTX; u.rt = 0; u.ct = pn; u.aux = b; u.nt = 8; }
        return true; }
    case ST_D2C: {
        const int q = c - 192; if (i > 0 || q < 0 || q >= 32) return false;
        const int pn = q & 1, b = q >> 1;
        u.A = ws + WS_DCTX; u.B = ws + WS_YT + ((size_t)pn * 256 * YLD + 2 * (b * 256)) * 2;
        u.kind = EK_DFT_CTX; u.rt = 0; u.ct = pn; u.aux = b; u.nt = 8; return true; }
    case ST_G4: {
        const int L = (i >> 1) * G + c, sub = i & 1; if (L >= 48 * 4) return false;
        int pm, pn; tile_order(L, 48, 4, pm, pn);
        const size_t ko = sub == 0 ? 1024 * 2 : 0;
        u.A = ws + WS_RGFF + (size_t)pm * 256 * 1536 * 2 + ko; u.B = ws + WS_WLOFO + (size_t)pn * 256 * 1536 * 2 + ko;
        u.kind = sub == 0 ? EK_G4A : EK_G4B; u.rt = pm; u.ct = pn; u.nt = sub == 0 ? 8 : 16; return true; }
    case ST_G5: {
        const int L = i * G + c; if (L >= 48 * 4) return false;
        int pm, pn; tile_order(L, 48, 4, pm, pn);
        u.A = ws + WS_XC + (size_t)pm * 256 * 1024 * 2; u.B = ws + WS_WOUT + (size_t)pn * 256 * 1024 * 2;
        u.kind = EK_RES1; u.rt = pm; u.ct = pn; u.nt = 16; return true; }
    case ST_K: {
        const int L = i * G + c; if (L >= 48 * 22) return false;
        int pm, pn; tile_order(L, 48, 22, pm, pn);
        u.A = ws + WS_H + (size_t)pm * 256 * 1024 * 2; u.B = ws + WS_WFFI + (size_t)pn * 256 * 1024 * 2;
        u.kind = EK_SWIGLU; u.rt = pm; u.ct = pn; u.nt = 16; return true; }
    case ST_L: {
        const int L = i * G + c; if (L >= 48 * 4) return false;
        int pm, pn; tile_order(L, 48, 4, pm, pn);
        u.A = ws + WS_BIG + (size_t)pm * 256 * 2816 * 2; u.B = ws + WS_WFFO + (size_t)pn * 256 * 2816 * 2;
        u.kind = EK_RES2; u.rt = pm; u.ct = pn; u.nt = 44; return true; }
    default: return false;
    }
}

constexpr int LDS_RSTD = STAGE_BYTES + 256;
constexpr int LDS_RSSP = STAGE_BYTES + 256 + 1024;
constexpr int LDS_BIASP = LDS_RSSP + 16384;
__device__ __forceinline__ void epi_prefetch(const Params& p, int layer, const UnitD& u, LAS unsigned char* lds, int wid, int lane) {
    const int k = u.kind;
    if (k == EK_RES1 || k == EK_RES2) {
        if (wid < 3) { const int mr = modrow_of_tile(u.rt), nl = k == EK_RES1 ? layer : (layer < 3 ? layer + 1 : layer);
            const float* src = wid == 0 ? (const float*)(p.ws + WS_MOD) + (size_t)((layer * 5 + mr) * 6 + (k == EK_RES1 ? 2 : 5)) * 1024
                             : wid == 1 ? (k == EK_RES1 ? p.norm2_g : p.norm1_g) + nl * 1024
                                        : (const float*)(p.ws + WS_MOD) + (size_t)((nl * 5 + mr) * 6 + (k == EK_RES1 ? 4 : 1)) * 1024;
            unsigned lo2 = (unsigned)lane * 16u; asm volatile("" : "+v"(lo2));
            __builtin_amdgcn_global_load_lds((const unsigned*)((const char*)(src + u.ct * 256) + lo2), (LAS unsigned*)(lds + LDS_BIASP + wid * 1024), 16, 0, 0); }
        return; }
    if (!(k == EK_XR || k == EK_GY || k == EK_SG || k == EK_YT || k == EK_SWIGLU)) return;
    const int tile = k == EK_YT ? u.ct : u.rt;
    const float* rssg = (const float*)(p.ws + WS_RSS) + (size_t)tile * 4096;
    const float* bias = k == EK_SWIGLU ? (const float*)(p.ws + WS_BM2) + modrow_of_tile(tile) * 5632 + u.ct * 256
                      : k == EK_YT     ? (const float*)(p.ws + WS_BM1) + modrow_of_tile(tile) * NIN5 + 2048 + u.rt * 256
                                       : (const float*)(p.ws + WS_BM1) + modrow_of_tile(tile) * NIN5 + u.ct * 256;
    unsigned lo = (unsigned)lane * 16u;
    asm volatile("" : "+v"(lo));
#pragma unroll
    for (int i = 0; i < 2; ++i)
        __builtin_amdgcn_global_load_lds((const unsigned*)((const char*)rssg + (size_t)(i * 8192 + wid * 1024) + lo), (LAS unsigned*)(lds + LDS_RSSP + i * 8192 + wid * 1024), 16, 0, 0);
    if (wid == 0) __builtin_amdgcn_global_load_lds((const unsigned*)((const char*)bias + lo), (LAS unsigned*)(lds + LDS_BIASP), 16, 0, 0);
}
__device__ __forceinline__ const LAS float* rstd_to_lds(LAS unsigned char* lds) {
    LAS float* rs = (LAS float*)(lds + LDS_RSTD);
    const int t = otid();
    if (t < 256) { const LAS f32x4* rp = (const LAS f32x4*)(lds + LDS_RSSP) + t * 4;
        const f32x4 s4 = (rp[0] + rp[1]) + (rp[2] + rp[3]);
        rs[t] = rsqrtf(((s4.x + s4.y) + (s4.z + s4.w)) * (1.f / 1024.f) + 1e-6f); }
    asm volatile("s_waitcnt lgkmcnt(0)" ::: "memory"); __builtin_amdgcn_s_barrier(); asm volatile("" ::: "memory");
    return rs;
}

__device__ __forceinline__ void epilogue(const Params& p, int layer, const UnitD& u, f32x4 (&acc)[2][2][4][2], int wr, int wc, int fr, int fq, LAS unsigned char* lds) {
    unsigned char* ws = p.ws;
    int rl = wr * 64 + fr;
    int cl = wc * 32 + 8 * fq;
    asm volatile("" : "+v"(rl), "+v"(cl));
    switch (u.kind) {
    case EK_XR: case EK_GY: case EK_SG: {
        const LAS float* bias = (const LAS float*)(lds + LDS_BIASP) + cl;
        const LAS float* rsl = rstd_to_lds(lds);
        f32x4 bv[2][2];
#pragma unroll
        for (int bj = 0; bj < 2; ++bj) { bv[bj][0] = *(const LAS f32x4*)(bias + bj * 128); bv[bj][1] = *(const LAS f32x4*)(bias + bj * 128 + 4); }
        bf16_t* base; int ld;
        if (u.kind == EK_XR) { base = (bf16_t*)(ws + WS_XR) + u.ct * 256; ld = 1024; }
        else if (u.kind == EK_GY) { base = (bf16_t*)(ws + WS_GY) + (u.ct - 4) * 256; ld = 1024; }
        else { base = (bf16_t*)(ws + WS_SG) + (u.ct - 12) * 256; ld = 2048; }
#pragma unroll
        for (int ai = 0; ai < 2; ++ai)
#pragma unroll
            for (int m = 0; m < 4; ++m) {
                const int row = u.rt * 256 + rl + ai * 128 + m * 16;
                bf16_t* rowp = base + (size_t)row * ld + cl;
                const float rstd = rsl[rl + ai * 128 + m * 16];
#pragma unroll
                for (int bj = 0; bj < 2; ++bj) {
                    f32x4 v0 = acc[ai][bj][m][0] * rstd + bv[bj][0], v1 = acc[ai][bj][m][1] * rstd + bv[bj][1];
                    if (u.kind == EK_GY) {
#pragma unroll
                        for (int j = 0; j < 4; ++j) { v0[j] = gelu_tanh_f(v0[j]); v1[j] = gelu_tanh_f(v1[j]); }
                    } else if (u.kind == EK_SG) {
#pragma unroll
                        for (int j = 0; j < 4; ++j) { v0[j] = sigmoid_f(v0[j]); v1[j] = sigmoid_f(v1[j]); }
                    }
                    u32x4 w; w.x = cvt_pk_bf16(v0[0], v0[1]); w.y = cvt_pk_bf16(v0[2], v0[3]); w.z = cvt_pk_bf16(v1[0], v1[1]); w.w = cvt_pk_bf16(v1[2], v1[3]);
                    *(u32x4*)(rowp + bj * 128) = w;
                }
            }
        break; }
    case EK_YT: {
        const int tt = u.ct;
        int seqbase, Ls, pos0;
        if (tt < 16) { seqbase = tt * 256; Ls = 256; pos0 = 0; } else { const int s = (tt - 16) >> 3; seqbase = TCTX + s * 2048; Ls = 2048; pos0 = ((tt - 16) & 7) * 256; }
        const LAS float* bias = (const LAS float*)(lds + LDS_BIASP);
        bf16_t* yt = (bf16_t*)(ws + WS_YT);
        const LAS float* rsl = rstd_to_lds(lds);
        f32x4 rs[2][2];
#pragma unroll
        for (int bj = 0; bj < 2; ++bj)
#pragma unroll
            for (int n = 0; n < 2; ++n)
#pragma unroll
                for (int j = 0; j < 4; ++j) rs[bj][n][j] = rsl[cl + bj * 128 + n * 4 + j];
#pragma unroll
        for (int ai = 0; ai < 2; ++ai)
#pragma unroll
            for (int m = 0; m < 4; ++m) {
                const int n = u.rt * 256 + rl + ai * 128 + m * 16;
                const float bb = bias[rl + ai * 128 + m * 16];
                const int part = n >> 9, nn = n & 511;
                bf16_t* rowp = yt + (size_t)nn * YLD + 2 * seqbase + part * Ls + pos0 + cl;
#pragma unroll
                for (int bj = 0; bj < 2; ++bj) {
                    const f32x4 v0 = acc[ai][bj][m][0] * rs[bj][0] + bb, v1 = acc[ai][bj][m][1] * rs[bj][1] + bb;
                    u32x4 w; w.x = cvt_pk_bf16(v0[0], v0[1]); w.y = cvt_pk_bf16(v0[2], v0[3]); w.z = cvt_pk_bf16(v1[0], v1[1]); w.w = cvt_pk_bf16(v1[2], v1[3]);
                    *(u32x4*)(rowp + bj * 128) = w;
                }
            }
        break; }
    case EK_GATE: {
        const int h = u.aux, dir = u.ct >> 1;
        const int e0 = h * 256 + (u.ct & 1) * 128 + cl;
        const int pofs = (layer * 2 + dir) * 1024 + e0;
        f32x4 ba[2], bx[2], sp[2];
#pragma unroll
        for (int n = 0; n < 2; ++n) {
            ba[n] = *(const f32x4*)(p.lru_ba + pofs + 4 * n); bx[n] = *(const f32x4*)(p.lru_bx + pofs + 4 * n);
            sp[n] = *(const f32x4*)((const float*)(ws + WS_SP) + (dir * 1024 + e0) + 4 * n);
        }
        const bf16_t* xc = (const bf16_t*)(ws + WS_XC);
        bf16_t* la = (bf16_t*)(ws + WS_LA) + (size_t)dir * T * 1024;
        bf16_t* bbp = (bf16_t*)(ws + WS_BB) + (size_t)dir * T * 1024;
        u32x4 xall[2][4];
#pragma unroll
        for (int ai = 0; ai < 2; ++ai)
#pragma unroll
            for (int m = 0; m < 4; ++m) xall[ai][m] = *(const u32x4*)(xc + (size_t)(u.rt * 256 + rl + ai * 128 + m * 16) * 1024 + e0);
#pragma unroll
        for (int ai = 0; ai < 2; ++ai)
#pragma unroll
            for (int m = 0; m < 4; ++m) {
                const size_t ro = (size_t)(u.rt * 256 + rl + ai * 128 + m * 16) * 1024 + e0;
                const u32x4 xv = xall[ai][m];
                float xf[8] = {bf_lo(xv.x), bf_hi(xv.x), bf_lo(xv.y), bf_hi(xv.y), bf_lo(xv.z), bf_hi(xv.z), bf_lo(xv.w), bf_hi(xv.w)};
                float lo[8], bo[8];
#pragma unroll
                for (int n = 0; n < 2; ++n)
#pragma unroll
                    for (int j = 0; j < 4; ++j) {
                        const float r = sigmoid_f(acc[ai][0][m][n][j] + ba[n][j]);
                        const float ig = sigmoid_f(acc[ai][1][m][n][j] + bx[n][j]);
                        const float l = r * sp[n][j];
                        const float x2 = 2.f * l;
                        const float ser = -x2 * (1.f + x2 * (0.5f + x2 * (0.16666667f + x2 * 0.041666668f)));
                        const float om = x2 > -0.06f ? ser : 1.f - __expf(x2);
                        const float mult = __builtin_amdgcn_sqrtf(fmaxf(om, 0.f));
                        lo[4 * n + j] = l; bo[4 * n + j] = mult * ig * xf[4 * n + j];
                    }
                u32x4 w; w.x = cvt_pk_bf16(lo[0], lo[1]); w.y = cvt_pk_bf16(lo[2], lo[3]); w.z = cvt_pk_bf16(lo[4], lo[5]); w.w = cvt_pk_bf16(lo[6], lo[7]);
                *(u32x4*)(la + ro) = w;
                w.x = cvt_pk_bf16(bo[0], bo[1]); w.y = cvt_pk_bf16(bo[2], bo[3]); w.z = cvt_pk_bf16(bo[4], bo[5]); w.w = cvt_pk_bf16(bo[6], bo[7]);
                *(u32x4*)(bbp + ro) = w;
            }
        break; }
    case EK_DFT_LAT: case EK_DFT_CTX: {
        bf16_t* base; int ld; float sc;
        if (u.kind == EK_DFT_LAT) { const int b = u.aux >> 2, ks = u.aux & 3; base = (bf16_t*)(ws + WS_FFP) + ((size_t)ks * 8192 + b * 2048 + u.rt * 256) * 512 + u.ct * 256; ld = 512; sc = 0.0027621358640099515f; }
        else { base = (bf16_t*)(ws + WS_RGFF) + (size_t)(u.aux * 256) * 1536 + 1024 + u.ct * 256; ld = 1536; sc = 0.0078125f; }
#pragma unroll
        for (int ai = 0; ai < 2; ++ai)
#pragma unroll
            for (int m = 0; m < 4; ++m) {
                bf16_t* rowp = base + (size_t)(rl + ai * 128 + m * 16) * ld + cl;
#pragma unroll
                for (int bj = 0; bj < 2; ++bj) {
                    const f32x4 v0 = acc[ai][bj][m][0] * sc, v1 = acc[ai][bj][m][1] * sc;
                    u32x4 w; w.x = cvt_pk_bf16(v0[0], v0[1]); w.y = cvt_pk_bf16(v0[2], v0[3]); w.z = cvt_pk_bf16(v1[0], v1[1]); w.w = cvt_pk_bf16(v1[2], v1[3]);
                    *(u32x4*)(rowp + bj * 128) = w;
                }
            }
        break; }
    case EK_G4B: {
        const bf16_t* sg = (const bf16_t*)(ws + WS_SG) + u.ct * 256 + cl;
        bf16_t* mo = (bf16_t*)(ws + WS_XC) + u.ct * 256 + cl;
        u32x4 gall[2][4][2];
#pragma unroll
        for (int ai = 0; ai < 2; ++ai)
#pragma unroll
            for (int m = 0; m < 4; ++m)
#pragma unroll
                for (int bj = 0; bj < 2; ++bj) gall[ai][m][bj] = *(const u32x4*)(sg + (size_t)(u.rt * 256 + rl + ai * 128 + m * 16) * 2048 + bj * 128);
#pragma unroll
        for (int ai = 0; ai < 2; ++ai)
#pragma unroll
            for (int m = 0; m < 4; ++m) {
                const size_t row = (size_t)(u.rt * 256 + rl + ai * 128 + m * 16);
#pragma unroll
                for (int bj = 0; bj < 2; ++bj) {
                    const u32x4 av = gall[ai][m][bj];
                    f32x4 a0 = {bf_lo(av.x), bf_hi(av.x), bf_lo(av.y), bf_hi(av.y)}, a1 = {bf_lo(av.z), bf_hi(av.z), bf_lo(av.w), bf_hi(av.w)};
#pragma unroll
                    for (int j = 0; j < 4; ++j) { a0[j] = fmaxf(a0[j], 1e-30f); a1[j] = fmaxf(a1[j], 1e-30f); }
                    const f32x4 v0 = a0 * acc[ai][bj][m][0], v1 = a1 * acc[ai][bj][m][1];
                    u32x4 w; w.x = cvt_pk_bf16(v0[0], v0[1]); w.y = cvt_pk_bf16(v0[2], v0[3]); w.z = cvt_pk_bf16(v1[0], v1[1]); w.w = cvt_pk_bf16(v1[2], v1[3]);
                    *(u32x4*)(mo + row * 1024 + bj * 128) = w;
                }
            }
        break; }
    case EK_RES1: case EK_RES2: {
        const bool emit = (u.kind == EK_RES1) || (layer < 3);
        const LAS float* colp = (const LAS float*)(lds + LDS_BIASP) + cl;
        char* xb_b = (char*)(ws + WS_XB); char* xg_b = (char*)(ws + WS_H); char* rss_b = (char*)(ws + WS_RSS);
        const unsigned e0 = (unsigned)((u.rt * 256 + rl) * 1024 + u.ct * 256 + cl);
        const unsigned r0 = (unsigned)((u.rt * 256 + rl) * 16 + u.ct * 4 + wc);
#pragma unroll
        for (int ai = 0; ai < 2; ++ai) {
            u32x4 xl[4][2];
#pragma unroll
            for (int m = 0; m < 4; ++m)
#pragma unroll
                for (int bj = 0; bj < 2; ++bj) { const unsigned eo = e0 + (unsigned)((ai * 128 + m * 16) * 1024 + bj * 128);
                    xl[m][bj] = *(const u32x4*)(xb_b + (size_t)eo * 2); }
#pragma unroll
            for (int m = 0; m < 4; ++m) {
                float ss = 0.f;
#pragma unroll
                for (int bj = 0; bj < 2; ++bj) {
                    const unsigned eo = e0 + (unsigned)((ai * 128 + m * 16) * 1024 + bj * 128);
                    const u32x4 xo = xl[m][bj];
                    const f32x4 g0 = *(const LAS f32x4*)(colp + bj * 128), g1 = *(const LAS f32x4*)(colp + bj * 128 + 4);
                    const f32x4 x0 = (f32x4){bf_lo(xo.x), bf_hi(xo.x), bf_lo(xo.y), bf_hi(xo.y)} + g0 * acc[ai][bj][m][0], x1 = (f32x4){bf_lo(xo.z), bf_hi(xo.z), bf_lo(xo.w), bf_hi(xo.w)} + g1 * acc[ai][bj][m][1];
                    { u32x4 w; w.x = cvt_pk_bf16(x0[0], x0[1]); w.y = cvt_pk_bf16(x0[2], x0[3]); w.z = cvt_pk_bf16(x1[0], x1[1]); w.w = cvt_pk_bf16(x1[2], x1[3]);
                      *(u32x4*)(xb_b + (size_t)eo * 2) = w; }
                    ss += ((x0.x * x0.x + x0.y * x0.y) + (x0.z * x0.z + x0.w * x0.w)) + ((x1.x * x1.x + x1.y * x1.y) + (x1.z * x1.z + x1.w * x1.w));
                    if (emit) { const f32x4 s0 = *(const LAS f32x4*)(colp + 256 + bj * 128) * (*(const LAS f32x4*)(colp + 512 + bj * 128) + 1.f), s1 = *(const LAS f32x4*)(colp + 256 + bj * 128 + 4) * (*(const LAS f32x4*)(colp + 512 + bj * 128 + 4) + 1.f);
                        const f32x4 y0 = x0 * s0, y1 = x1 * s1;
                        u32x4 w; w.x = cvt_pk_bf16(y0[0], y0[1]); w.y = cvt_pk_bf16(y0[2], y0[3]); w.z = cvt_pk_bf16(y1[0], y1[1]); w.w = cvt_pk_bf16(y1[2], y1[3]);
                        *(u32x4*)(xg_b + (size_t)eo * 2) = w; }
                }
                ss += shx<16>(ss, fr + 16 * fq); ss += shx<32>(ss, fr + 16 * fq);
                if (fq == 0) *(float*)(rss_b + (size_t)(r0 + (unsigned)((ai * 128 + m * 16) * 16)) * 4) = ss;
            }
        }
        break; }
    case EK_SWIGLU: {
        bf16_t* so = (bf16_t*)(ws + WS_BIG) + u.ct * 128 + cl;
        const LAS float* bias = (const LAS float*)(lds + LDS_BIASP) + cl;
        const LAS float* rsl = rstd_to_lds(lds);
        f32x4 bv[2][2];
#pragma unroll
        for (int bj = 0; bj < 2; ++bj) { bv[bj][0] = *(const LAS f32x4*)(bias + bj * 128); bv[bj][1] = *(const LAS f32x4*)(bias + bj * 128 + 4); }
#pragma unroll
        for (int ai = 0; ai < 2; ++ai)
#pragma unroll
            for (int m = 0; m < 4; ++m) {
                const int row = u.rt * 256 + rl + ai * 128 + m * 16;
                const float rstd = rsl[rl + ai * 128 + m * 16];
                float o[8];
#pragma unroll
                for (int n = 0; n < 2; ++n)
#pragma unroll
                    for (int j = 0; j < 4; ++j) { const float uu = acc[ai][0][m][n][j] * rstd + bv[0][n][j], vv = acc[ai][1][m][n][j] * rstd + bv[1][n][j]; o[4 * n + j] = uu * sigmoid_f(uu) * vv; }
                u32x4 w; w.x = cvt_pk_bf16(o[0], o[1]); w.y = cvt_pk_bf16(o[2], o[3]); w.z = cvt_pk_bf16(o[4], o[5]); w.w = cvt_pk_bf16(o[6], o[7]);
                *(u32x4*)(so + (size_t)row * DFF) = w;
            }
        break; }
    default: break;
    }
}

__device__ __forceinline__ void g4a_rescale(const Params& p, const UnitD& u, f32x4 (&acc)[2][2][4][2], int wr, int wc, int fr, int fq) {
    int rl = wr * 64 + fr, cl = wc * 32 + 8 * fq;
    asm volatile("" : "+v"(rl), "+v"(cl));
    const bf16_t* sg = (const bf16_t*)(p.ws + WS_SG) + u.ct * 256 + cl;
#pragma unroll
    for (int ai = 0; ai < 2; ++ai) {
        u32x4 al[4][2], gl[4][2];
#pragma unroll
        for (int m = 0; m < 4; ++m)
#pragma unroll
            for (int bj = 0; bj < 2; ++bj) { const size_t row = (size_t)(u.rt * 256 + rl + ai * 128 + m * 16);
                al[m][bj] = *(const u32x4*)(sg + row * 2048 + bj * 128); gl[m][bj] = *(const u32x4*)(sg + row * 2048 + 1024 + bj * 128); }
#pragma unroll
        for (int m = 0; m < 4; ++m) {
#pragma unroll
            for (int bj = 0; bj < 2; ++bj) {
                const u32x4 av = al[m][bj];
                const u32x4 gv = gl[m][bj];
                const float a[8] = {bf_lo(av.x), bf_hi(av.x), bf_lo(av.y), bf_hi(av.y), bf_lo(av.z), bf_hi(av.z), bf_lo(av.w), bf_hi(av.w)};
                const float g[8] = {bf_lo(gv.x), bf_hi(gv.x), bf_lo(gv.y), bf_hi(gv.y), bf_lo(gv.z), bf_hi(gv.z), bf_lo(gv.w), bf_hi(gv.w)};
#pragma unroll
                for (int j = 0; j < 4; ++j) { acc[ai][bj][m][0][j] *= g[j] * frcp(fmaxf(a[j], 1e-30f)); acc[ai][bj][m][1][j] *= g[4 + j] * frcp(fmaxf(a[4 + j], 1e-30f)); }
            }
        }
        asm volatile("" ::: "memory");
    }
}

__device__ __forceinline__ void gemm_phase(LAS unsigned char* lds, const Params& p, const int step, const int layer, const int lda, const int ldb) {
    const int tid = otid(), wid = __builtin_amdgcn_readfirstlane(tid >> 6), lane = tid & 63, wr = wid >> 2, wc = wid & 3, fr = lane & 15, fq = lane >> 4;
    unsigned voffA[2], voffB[2];
#pragma unroll
    for (int i = 0; i < 2; ++i) { int R, C; stage_rc(tid * 16 + i * 8192, R, C); const int Rb = (R & ~31) + perm32(R & 31);
        voffA[i] = (unsigned)(R * lda + C) * 2u; voffB[i] = (unsigned)(Rb * ldb + C) * 2u; }
    const size_t kstep = (size_t)(BK * 2);
    const size_t hstepA = (size_t)HALF * lda * 2, hstepB = (size_t)HALF * ldb * 2;
    const unsigned ldsw = (unsigned)wid * 1024u;
    const int aoff = lds_byte(wr * 64 + fr, fq * 8), boff = lds_byte(wc * 32 + fr, fq * 8);
#define G_SA(b, h) (((b) * 2 + (h)) * HTB)
#define G_SB(b, h) ((4 + (b) * 2 + (h)) * HTB)
#define G_STAGE(bufoff, gbase, voff) do { _Pragma("unroll") for (int _i = 0; _i < 2; ++_i) \
        __builtin_amdgcn_global_load_lds((const unsigned*)((const char*)(gbase) + (voff)[_i]), (LAS unsigned*)(lds + (bufoff) + ldsw + _i * 8192), 16, 0, 0); } while (0)
#define G_LDA(dst, b, h) do { _Pragma("unroll") for (int m = 0; m < 4; ++m) _Pragma("unroll") for (int k = 0; k < 2; ++k) dst[m][k] = *(const LAS bf16x8*)(lds + G_SA(b, h) + aoff + m * 2048 + k * 1024); } while (0)
#define G_LDB(dst, b, h) do { _Pragma("unroll") for (int n = 0; n < 2; ++n) _Pragma("unroll") for (int k = 0; k < 2; ++k) dst[n][k] = *(const LAS bf16x8*)(lds + G_SB(b, h) + boff + n * 2048 + k * 1024); } while (0)
#define G_MMA(ai, bj, At, Bt) do { __builtin_amdgcn_s_setprio(1); _Pragma("unroll") for (int m = 0; m < 4; ++m) _Pragma("unroll") for (int n = 0; n < 2; ++n) _Pragma("unroll") for (int k = 0; k < 2; ++k) \
        acc[ai][bj][m][n] = __builtin_amdgcn_mfma_f32_16x16x32_bf16(Bt[n][k], At[m][k], acc[ai][bj][m][n], 0, 0, 0); __builtin_amdgcn_s_setprio(0); } while (0)
#define G_WAIT_V(n) asm volatile("s_waitcnt vmcnt(" #n ")" ::: "memory")
#define G_WAIT_L(n) asm volatile("s_waitcnt lgkmcnt(" #n ")" ::: "memory")
#define G_BAR __builtin_amdgcn_s_barrier()
#define G_SCHED __builtin_amdgcn_sched_barrier(0)
    UnitD cur, nxt; int ui = 0;
    if (!get_unit(p, step, 0, cur)) return;
    f32x4 acc[2][2][4][2];
#pragma unroll
    for (int a = 0; a < 2; ++a)
#pragma unroll
        for (int b = 0; b < 2; ++b)
#pragma unroll
            for (int m = 0; m < 4; ++m)
#pragma unroll
                for (int n = 0; n < 2; ++n) acc[a][b][m][n] = (f32x4){0.f, 0.f, 0.f, 0.f};
    bf16x8 At[4][2], B0[2][2], B1[2][2];
    const char* cA = cur.A; const char* cB = cur.B;
    G_STAGE(G_SB(0, 0), cB, voffB); G_STAGE(G_SB(0, 1), cB + hstepB, voffB); G_STAGE(G_SA(0, 0), cA, voffA); G_STAGE(G_SA(0, 1), cA + hstepA, voffA);
    if (wr == 1) G_BAR;
    G_WAIT_V(2); G_BAR;
    G_STAGE(G_SB(1, 0), cB + kstep, voffB); G_STAGE(G_SA(1, 0), cA + kstep, voffA); G_STAGE(G_SB(1, 1), cB + hstepB + kstep, voffB);
    G_WAIT_V(6); G_BAR;
    for (;;) {
        epi_prefetch(p, layer, cur, lds, wid, lane);
        const bool has_next = get_unit(p, step, ui + 1, nxt);
        const char* nA = has_next ? nxt.A : cA; const char* nB = has_next ? nxt.B : cB;
        const int nt = cur.nt;
        for (int t = 0; t < nt; t += 2) {
            const bool last = (t == nt - 2);
            const char* a1 = cA + (size_t)(t + 1) * kstep;
            const char* a2 = last ? nA : cA + (size_t)(t + 2) * kstep; const char* b2 = last ? nB : cB + (size_t)(t + 2) * kstep;
            const char* a3 = a2 + kstep; const char* b3 = b2 + kstep;
            G_LDB(B0, 0, 0); G_LDB(B1, 0, 1); G_SCHED; G_LDA(At, 0, 0); G_STAGE(G_SA(1, 1), a1 + hstepA, voffA);
            G_WAIT_V(8); G_WAIT_L(0); G_BAR; G_MMA(0, 0, At, B0); G_MMA(0, 1, At, B1); G_BAR; G_SCHED;
            G_LDA(At, 0, 1); G_STAGE(G_SB(0, 0), b2, voffB); G_STAGE(G_SB(0, 1), b2 + hstepB, voffB); G_STAGE(G_SA(0, 0), a2, voffA);
            G_WAIT_V(8); G_WAIT_L(0); G_BAR; G_MMA(1, 0, At, B0); G_MMA(1, 1, At, B1); G_BAR; G_SCHED;
            G_LDB(B0, 1, 0); G_LDB(B1, 1, 1); G_SCHED; G_LDA(At, 1, 0); G_STAGE(G_SA(0, 1), a2 + hstepA, voffA);
            G_WAIT_V(8); G_WAIT_L(0); G_BAR; G_MMA(0, 0, At, B0); G_MMA(0, 1, At, B1); G_BAR; G_SCHED;
            G_LDA(At, 1, 1); G_STAGE(G_SB(1, 0), b3, voffB); G_STAGE(G_SB(1, 1), b3 + hstepB, voffB); G_STAGE(G_SA(1, 0), a3, voffA);
            G_WAIT_V(8); G_WAIT_L(0); G_BAR; G_MMA(1, 0, At, B0); G_MMA(1, 1, At, B1); G_BAR; G_SCHED;
        }
        if (wr == 0) G_BAR;
        if (cur.kind == EK_G4A) g4a_rescale(p, cur, acc, wr, wc, fr, fq);
        else epilogue(p, layer, cur, acc, wr, wc, fr, fq, lds);
        if (!has_next) break;
        if (cur.kind != EK_G4A)
#pragma unroll
        for (int a = 0; a < 2; ++a)
#pragma unroll
            for (int b = 0; b < 2; ++b)
#pragma unroll
                for (int m = 0; m < 4; ++m)
#pragma unroll
                    for (int n = 0; n < 2; ++n) acc[a][b][m][n] = (f32x4){0.f, 0.f, 0.f, 0.f};
        cur = nxt; cA = nA; cB = nB; ++ui;
        if (wr == 1) G_BAR;
        G_BAR;
    }
    G_WAIT_V(0);
    G_BAR;
#undef G_SA
#undef G_SB
#undef G_STAGE
#undef G_LDA
#undef G_LDB
#undef G_MMA
#undef G_WAIT_V
#undef G_WAIT_L
#undef G_BAR
#undef G_SCHED
}

__device__ __forceinline__ void phase_convert_weights(const Params& p, int l, int mask, int rank, int nranks, LAS unsigned char* lds);
__device__ __forceinline__ void phase_mod(const Params& p, int l_lo, int l_hi, int rank, int nranks, LAS unsigned char* lds) {
    const int tid = otid();
    LAS float* sv = (LAS float*)lds;
    LAS float* red = (LAS float*)(lds + 20480);
    __syncthreads();
    for (int i = tid; i < 5 * 1024; i += 512) { const float v = i < 1024 ? p.c_ctx[i] : p.c[i - 1024]; sv[i] = v / (1.f + __expf(-v)); }
    __syncthreads();
    float* mod = (float*)(p.ws + WS_MOD);
    for (int it = l_lo * 192 + rank; it < l_hi * 192; it += nranks) {
        const int l = it / 192, j0 = (it % 192) * 32, col = tid & 31, ks = tid >> 5;
        const float* w = p.ada_w + ((size_t)l * 1024 + ks * 64) * 6144 + j0 + col;
        float a0 = 0.f, a1 = 0.f, a2 = 0.f, a3 = 0.f, a4 = 0.f;
#pragma unroll 16
        for (int k = 0; k < 64; ++k) { const float wv = w[(size_t)k * 6144]; const int kk = ks * 64 + k;
            a0 += sv[kk] * wv; a1 += sv[1024 + kk] * wv; a2 += sv[2048 + kk] * wv; a3 += sv[3072 + kk] * wv; a4 += sv[4096 + kk] * wv; }
        red[(ks * 5 + 0) * 32 + col] = a0; red[(ks * 5 + 1) * 32 + col] = a1; red[(ks * 5 + 2) * 32 + col] = a2; red[(ks * 5 + 3) * 32 + col] = a3; red[(ks * 5 + 4) * 32 + col] = a4;
        __syncthreads();
        if (tid < 160) { const int r = tid >> 5, cc = tid & 31; float s = 0.f;
#pragma unroll
            for (int k2 = 0; k2 < 16; ++k2) s += red[(k2 * 5 + r) * 32 + cc];
            mod[(size_t)(l * 5 + r) * 6144 + j0 + cc] = s + p.ada_b[l * 6144 + j0 + cc]; }
        __syncthreads();
    }
}
__device__ __forceinline__ void phase_prep(const Params& p, LAS unsigned char* lds) {
    const int tid = otid(), G = gridDim.x, c = obid();
    unsigned char* ws = p.ws;
    LAS float* ct = (LAS float*)(lds + 32768);
    if (tid < 256) ct[tid] = cospif((float)tid * (1.f / 128.f));
    __syncthreads();
    { bf16_t* dc = (bf16_t*)(ws + WS_DCTX);
      for (int i = c * 512 + tid; i < 256 * 64; i += G * 512) { const int pp = i >> 6, k0 = (i & 63) * 8; float v[8];
#pragma unroll
          for (int j = 0; j < 8; ++j) { const int k = k0 + j, kk = k & 255; const int ph = (pp * kk) & 255; v[j] = k < 256 ? ct[ph] : -ct[(ph + 192) & 255]; }
          u32x4 w; w.x = cvt_pk_bf16(v[0], v[1]); w.y = cvt_pk_bf16(v[2], v[3]); w.z = cvt_pk_bf16(v[4], v[5]); w.w = cvt_pk_bf16(v[6], v[7]);
          *(u32x4*)(dc + (size_t)pp * 4096 + k0) = w; }
      bf16_t* dl = (bf16_t*)(ws + WS_DLAT);
      for (int i = c * 512 + tid; i < 2048 * 512; i += G * 512) { const int pp = i >> 9, k0 = (i & 511) * 8; const int r1 = pp >> 6, w1 = pp & 63; float v[8];
#pragma unroll
          for (int j = 0; j < 8; ++j) { const int k = k0 + j, part = k >> 11, pos = k & 2047, r = pos >> 6, w = pos & 63; const int ph = ((2 * r * r1 + w * w1) & 63) * 4;
              v[j] = part == 0 ? ct[ph] : -ct[(ph + 192) & 255]; }
          u32x4 w; w.x = cvt_pk_bf16(v[0], v[1]); w.y = cvt_pk_bf16(v[2], v[3]); w.z = cvt_pk_bf16(v[4], v[5]); w.w = cvt_pk_bf16(v[6], v[7]);
          *(u32x4*)(dl + (size_t)pp * 4096 + k0) = w; } }
    phase_convert_weights(p, 0, 31, c, G, lds);
    __syncthreads();
    phase_mod(p, 0, 1, c, G, lds);
}

__device__ __forceinline__ void tr_item(const float* src, int srcld, bf16_t* dst, int dstld, int lane, LAS float* scr) {
    const float* pp = src + (size_t)(lane >> 5) * srcld + (lane & 31);
    LAS float* sp = scr + (lane >> 5) * 33 + (lane & 31);
#pragma unroll
    for (int h = 0; h < 2; ++h) {
        float tv[16];
#pragma unroll
        for (int i = 0; i < 16; ++i) { tv[i] = *pp; pp += 2 * (size_t)srcld; }
#pragma unroll
        for (int i = 0; i < 16; ++i) sp[(h * 16 + i) * 66] = tv[i];
    }
    asm volatile("s_waitcnt lgkmcnt(0)" ::: "memory");
    const int c8 = lane & 7;
#pragma unroll
    for (int j = 0; j < 4; ++j) { const int n = (lane >> 3) + 8 * j; const LAS float* s = scr + (8 * c8) * 33 + n;
        u32x4 o; o.x = cvt_pk_bf16(s[0], s[33]); o.y = cvt_pk_bf16(s[2 * 33], s[3 * 33]); o.z = cvt_pk_bf16(s[4 * 33], s[5 * 33]); o.w = cvt_pk_bf16(s[6 * 33], s[7 * 33]);
        *(u32x4*)(dst + (size_t)n * dstld + 8 * c8) = o; }
    asm volatile("s_waitcnt lgkmcnt(0)" ::: "memory");
}

__device__ __forceinline__ void phase_convert_weights(const Params& p, int l, int mask, int rank, int nranks, LAS unsigned char* lds) {
    const int tid = otid(), wid = tid >> 6, lane = tid & 63, G = nranks, c = rank;
    unsigned char* ws = p.ws;
    LAS float* scr = (LAS float*)(lds + wid * 8448);
    LAS float* tw = (LAS float*)(lds + 8 * 8448);
    if (tid < 128) { const int j = tid & 63; tw[tid] = tid < 64 ? cospif((float)j * (1.f / 32.f)) : sinpif((float)j * (1.f / 32.f)); }
    __syncthreads();
    constexpr int I1 = 2048, I2 = 512, I3 = 768, I4 = 512, I5 = 2816, I6 = 1408, NIT = I1 + I2 + I3 + I4 + I5 + I6;
    const int gw = c * 8 + wid, NGW = G * 8;
    const int n0s = (mask & 1) ? I1 + I2 : 0, n1s = (mask & 2) ? I3 : 0, n2s = (mask & 4) ? I4 : 0, n3s = (mask & 8) ? I5 : 0, n4s = (mask & 16) ? I6 : 0;
    const int ntot = n0s + n1s + n2s + n3s + n4s;
    for (int q = gw; q < ntot; q += NGW) {
        int r = q;
        if (r < n0s) { }
        else { r -= n0s; if (r < n1s) r += I1 + I2; else { r -= n1s; if (r < n2s) r += I1 + I2 + I3; else { r -= n2s; if (r < n3s) r += I1 + I2 + I3 + I4; else { r -= n3s; r += I1 + I2 + I3 + I4 + I5; } } } }
        if (r < I1) { const int nb = r & 127, kb = r >> 7, k0 = kb * 64; const int n0 = nb < 64 ? nb * 32 : 3072 + (nb - 64) * 32, s0 = nb < 64 ? nb * 32 : 2560 + (nb - 64) * 32;
            tr_item(p.w_in + ((size_t)l * 1024 + k0) * NIN + s0, NIN, (bf16_t*)(ws + WS_WIN) + (size_t)n0 * 1024 + k0, 1024, lane, scr); continue; }
        r -= I1;
        if (r < I2) { const int mat = r >> 5, q = r & 31, kb = q >> 3, nb = q & 7, k0 = kb * 64, e0 = nb * 32; const int gate = mat >> 3, dir = (mat >> 2) & 1, h = mat & 3;
            const float* src = (gate ? p.lru_wx : p.lru_wa) + ((size_t)(((l * 2 + dir) * 4 + h) * 256 + k0)) * 256 + e0;
            const int n0 = 256 * (dir * 2 + (e0 >> 7)) + 128 * gate + (e0 & 127);
            tr_item(src, 256, (bf16_t*)(ws + WS_WG) + ((size_t)(h * 1024 + n0)) * 256 + k0, 256, lane, scr); continue; }
        r -= I2;
        if (r < I3) {
            if (r < 512) { const int kb = r >> 5, nb = r & 31; tr_item(p.w_lru_out + ((size_t)l * 1024 + kb * 64) * 1024 + nb * 32, 1024, (bf16_t*)(ws + WS_WLOFO) + (size_t)(nb * 32) * 1536 + kb * 64, 1536, lane, scr); }
            else { const int q = r - 512, kb = q >> 5, nb = q & 31; tr_item(p.w_fnet_out + ((size_t)l * 512 + kb * 64) * 1024 + nb * 32, 1024, (bf16_t*)(ws + WS_WLOFO) + (size_t)(nb * 32) * 1536 + 1024 + kb * 64, 1536, lane, scr); }
            continue; }
        r -= I3;
        if (r < I4) { const int kb = r >> 5, nb = r & 31; tr_item(p.w_out + ((size_t)l * 1024 + kb * 64) * 1024 + nb * 32, 1024, (bf16_t*)(ws + WS_WOUT) + (size_t)(nb * 32) * 1024 + kb * 64, 1024, lane, scr); continue; }
        r -= I4;
        if (r < I5) { const int kb = r / 176, nb = r % 176, n0 = nb * 32; const int pn = n0 >> 8, bj = (n0 >> 7) & 1, x = n0 & 127; const int s0 = bj * DFF + pn * 128 + x;
            tr_item(p.ffn_w_in + ((size_t)l * 1024 + kb * 64) * (2 * DFF) + s0, 2 * DFF, (bf16_t*)(ws + WS_WFFI) + (size_t)n0 * 1024 + kb * 64, 1024, lane, scr); continue; }
        r -= I5;
        { const int kb = r >> 5, nb = r & 31; tr_item(p.ffn_w_out + ((size_t)l * DFF + kb * 64) * 1024 + nb * 32, 1024, (bf16_t*)(ws + WS_WFFO) + (size_t)(nb * 32) * DFF + kb * 64, DFF, lane, scr); }
    }
    if (!(mask & 1)) return;
    for (int idx = c * 512 + tid; idx < 65536; idx += G * 512) {
        const int k = idx & 1023, rest = idx >> 10, q = rest & 3, part = (rest >> 2) & 1, g = rest >> 3;
        const f32x4* src = (const f32x4*)(p.w_in + ((size_t)l * 1024 + k) * NIN + 2048 + g * 64);
        const LAS float* tb = tw + part * 64;
        float o[16];
#pragma unroll
        for (int j = 0; j < 16; ++j) o[j] = 0.f;
#pragma unroll
        for (int c4 = 0; c4 < 16; ++c4) { const f32x4 wv = src[c4];
#pragma unroll
            for (int e = 0; e < 4; ++e) { const int cc = c4 * 4 + e; const float wvv = wv[e];
#pragma unroll
                for (int j = 0; j < 16; ++j) o[j] += wvv * tb[(cc * (q * 16 + j)) & 63]; } }
        bf16_t* dst = (bf16_t*)(ws + WS_WIN) + (size_t)(2048 + part * 512 + g * 64 + q * 16) * 1024 + k;
#pragma unroll
        for (int j = 0; j < 16; ++j) dst[(size_t)j * 1024] = (bf16_t)(cvt_pk_bf16(o[j], 0.f) & 0xffffu);
    }
    float* bias = (float*)(ws + WS_BIAS);
    for (int n = c * 512 + tid; n < NIN5; n += G * 512) {
        float v;
        if (n < 2048) v = p.b_in[l * NIN + n];
        else if (n >= 3072) v = p.b_in[l * NIN + n - 512];
        else { const int q = n - 2048, part = q >> 9, g = (q >> 6) & 7, cp = q & 63; const float* b = p.b_in + l * NIN + 2048 + g * 64; const LAS float* tb = tw + part * 64; v = 0.f;
            for (int cc = 0; cc < 64; ++cc) v += b[cc] * tb[(cc * cp) & 63]; }
        bias[n] = v;
    }
    float* spt = (float*)(ws + WS_SP);
    for (int n = c * 512 + tid; n < 2048; n += G * 512) spt[n] = -8.f * log1pf(__expf(-p.lru_lambda[l * 2048 + n]));
}

__device__ __forceinline__ void phase_a0(const Params& p) {
    const int tid = otid(), wid = tid >> 6, lane = tid & 63, bid = obid();
    for (int row = bid * 8 + wid; row < T; row += gridDim.x * 8) {
        const float* xsrc = row < TCTX ? p.x_prompt + (size_t)row * 1024 : p.x_sample + (size_t)(row - TCTX) * 1024;
        const f32x4* xr = (const f32x4*)xsrc + lane;
        f32x4 v[4]; float s = 0.f;
#pragma unroll
        for (int j = 0; j < 4; ++j) { v[j] = xr[64 * j]; s += (v[j].x * v[j].x + v[j].y * v[j].y) + (v[j].z * v[j].z + v[j].w * v[j].w); }
        s = wave_sum(s, lane);
        const int mr = row < TCTX ? 0 : 1 + ((row - TCTX) >> 11);
        const float* mod = (const float*)(p.ws + WS_MOD) + (size_t)(mr * 6 + 1) * 1024;
        u32x2* o8 = (u32x2*)((bf16_t*)(p.ws + WS_H) + (size_t)row * 1024) + lane;
#pragma unroll
        for (int j = 0; j < 4; ++j) {
            const f32x4 g = *((const f32x4*)p.norm1_g + lane + 64 * j), sc = *((const f32x4*)mod + lane + 64 * j);
            const f32x4 y = v[j] * g * (sc + 1.f);
            u32x2 w; w.x = cvt_pk_bf16(y.x, y.y); w.y = cvt_pk_bf16(y.z, y.w); o8[64 * j] = w;
            u32x2 wx; wx.x = cvt_pk_bf16(v[j].x, v[j].y); wx.y = cvt_pk_bf16(v[j].z, v[j].w); ((u32x2*)((bf16_t*)(p.ws + WS_XB) + (size_t)row * 1024) + lane)[64 * j] = wx;
        }
        if (lane < 16) ((float*)(p.ws + WS_RSS))[(size_t)row * 16 + lane] = lane == 0 ? s : 0.f;
    }
}
__device__ __forceinline__ void phase_biasmod(const Params& p, const bf16_t* Wt, int nrows, const float* shift0  , const float* bias, float* out, int ldo, int rank, int nranks) {
    const int tid = otid(), wid = tid >> 6, lane = tid & 63, bid = rank;
    float sh[5][16];
#pragma unroll
    for (int r = 0; r < 5; ++r)
#pragma unroll
        for (int q = 0; q < 2; ++q) { const f32x4 a = *(const f32x4*)(shift0 + (size_t)r * 6144 + lane * 16 + q * 8), b = *(const f32x4*)(shift0 + (size_t)r * 6144 + lane * 16 + q * 8 + 4);
            sh[r][q * 8 + 0] = a.x; sh[r][q * 8 + 1] = a.y; sh[r][q * 8 + 2] = a.z; sh[r][q * 8 + 3] = a.w; sh[r][q * 8 + 4] = b.x; sh[r][q * 8 + 5] = b.y; sh[r][q * 8 + 6] = b.z; sh[r][q * 8 + 7] = b.w; }
    for (int n = bid * 8 + wid; n < nrows; n += nranks * 8) {
        const u32x4 w0 = *(const u32x4*)(Wt + (size_t)n * 1024 + lane * 16), w1 = *(const u32x4*)(Wt + (size_t)n * 1024 + lane * 16 + 8);
        const float wf[16] = {bf_lo(w0.x), bf_hi(w0.x), bf_lo(w0.y), bf_hi(w0.y), bf_lo(w0.z), bf_hi(w0.z), bf_lo(w0.w), bf_hi(w0.w),
                              bf_lo(w1.x), bf_hi(w1.x), bf_lo(w1.y), bf_hi(w1.y), bf_lo(w1.z), bf_hi(w1.z), bf_lo(w1.w), bf_hi(w1.w)};
        float a[5];
#pragma unroll
        for (int r = 0; r < 5; ++r) { float s = 0.f;
#pragma unroll
            for (int k = 0; k < 16; ++k) s += sh[r][k] * wf[k];
            a[r] = wave_sum(s, lane); }
        if (lane < 5) { const float v = lane == 0 ? a[0] : lane == 1 ? a[1] : lane == 2 ? a[2] : lane == 3 ? a[3] : a[4]; out[(size_t)lane * ldo + n] = v + (bias ? bias[n] : 0.f); }
    }
}

__device__ __forceinline__ void phase_final(const Params& p) {
    const int tid = otid(), wid = tid >> 6, lane = tid & 63;
    for (int row = obid() * 8 + wid; row < T; row += gridDim.x * 8) {
        f32x4* xr = (f32x4*)(p.out + (size_t)row * 1024) + lane;
        const u32x2* xb = (const u32x2*)((const bf16_t*)(p.ws + WS_XB) + (size_t)row * 1024) + lane;
        f32x4 v[4]; float s = 0.f;
#pragma unroll
        for (int j = 0; j < 4; ++j) { const u32x2 q = xb[64 * j]; v[j] = (f32x4){bf_lo(q.x), bf_hi(q.x), bf_lo(q.y), bf_hi(q.y)}; s += (v[j].x * v[j].x + v[j].y * v[j].y) + (v[j].z * v[j].z + v[j].w * v[j].w); }
        const float rstd = rsqrtf(wave_sum(s, lane) * (1.f / 1024.f) + 1e-6f);
#pragma unroll
        for (int j = 0; j < 4; ++j) { const f32x4 g = *((const f32x4*)p.final_g + lane + 64 * j); xr[64 * j] = v[j] * rstd * g; }
    }
}

__device__ __forceinline__ void phase_conv(const Params& p, int l) {
    const bf16_t* xr = (const bf16_t*)(p.ws + WS_XR); bf16_t* xc = (bf16_t*)(p.ws + WS_XC);
    for (int i = obid() * 512 + otid(); i < T * 128; i += gridDim.x * 512) {
        const int tok = i >> 7, c8 = (i & 127) * 8;
        int pos, Ls; if (tok < TCTX) { pos = tok & 255; Ls = 256; } else { pos = (tok - TCTX) & 2047; Ls = 2048; }
        const f32x4 b0 = *(const f32x4*)(p.conv_b + l * 1024 + c8), b1 = *(const f32x4*)(p.conv_b + l * 1024 + c8 + 4);
        float a[8] = {b0.x, b0.y, b0.z, b0.w, b1.x, b1.y, b1.z, b1.w};
#pragma unroll
        for (int k = 0; k < 4; ++k) { const int pp = pos + k - 2;
            if (pp >= 0 && pp < Ls) { const u32x4 v = *(const u32x4*)(xr + (size_t)(tok + k - 2) * 1024 + c8);
                const f32x4 w0 = *(const f32x4*)(p.conv_w + (l * 4 + k) * 1024 + c8), w1 = *(const f32x4*)(p.conv_w + (l * 4 + k) * 1024 + c8 + 4);
                a[0] += w0.x * bf_lo(v.x); a[1] += w0.y * bf_hi(v.x); a[2] += w0.z * bf_lo(v.y); a[3] += w0.w * bf_hi(v.y);
                a[4] += w1.x * bf_lo(v.z); a[5] += w1.y * bf_hi(v.z); a[6] += w1.z * bf_lo(v.w); a[7] += w1.w * bf_hi(v.w); } }
        u32x4 w; w.x = cvt_pk_bf16(a[0], a[1]); w.y = cvt_pk_bf16(a[2], a[3]); w.z = cvt_pk_bf16(a[4], a[5]); w.w = cvt_pk_bf16(a[6], a[7]);
        *(u32x4*)(xc + (size_t)tok * 1024 + c8) = w;
    }
}

__device__ __forceinline__ void phase_s1(const Params& p) {
    const int tid = otid(), G = gridDim.x;
    unsigned cl[16], cb[16];
    int it = obid();
    if (it < 2 * NCH) { const int dir = it & 1, ci = it >> 1;
        const unsigned* la = (const unsigned*)(p.ws + WS_LA + ((size_t)dir * T + ci * 16) * 1024 * 2) + tid;
        const unsigned* bb = (const unsigned*)(p.ws + WS_BB + ((size_t)dir * T + ci * 16) * 1024 * 2) + tid;
#pragma unroll
        for (int j = 0; j < 16; ++j) { const int jj = dir ? 15 - j : j; cl[j] = la[jj * 512]; cb[j] = bb[jj * 512]; } }
    for (; it < 2 * NCH; it += G) {
        unsigned nl[16], nb[16];
        const int nx = it + G;
        if (nx < 2 * NCH) { const int dir = nx & 1, ci = nx >> 1;
            const unsigned* la = (const unsigned*)(p.ws + WS_LA + ((size_t)dir * T + ci * 16) * 1024 * 2) + tid;
            const unsigned* bb = (const unsigned*)(p.ws + WS_BB + ((size_t)dir * T + ci * 16) * 1024 * 2) + tid;
#pragma unroll
            for (int j = 0; j < 16; ++j) { const int jj = dir ? 15 - j : j; nl[j] = la[jj * 512]; nb[j] = bb[jj * 512]; } }
        const int dir = it & 1, ci = it >> 1;
        float P0 = 1.f, P1 = 1.f, Q0 = 0.f, Q1 = 0.f;
#pragma unroll
        for (int j = 0; j < 16; ++j) { const unsigned l2 = cl[j], b2 = cb[j];
            const float a0 = __expf(bf_lo(l2)), a1 = __expf(bf_hi(l2)); P0 *= a0; P1 *= a1; Q0 = a0 * Q0 + bf_lo(b2); Q1 = a1 * Q1 + bf_hi(b2); }
        f32x4 o = {P0, Q0, P1, Q1};
        *((f32x4*)(p.ws + WS_SUMM) + ((size_t)(dir * NCH + ci) * 1024 + tid * 2) / 2) = o;
        if (nx < 2 * NCH) {
#pragma unroll
            for (int j = 0; j < 16; ++j) { cl[j] = nl[j]; cb[j] = nb[j]; } }
    }
}
__device__ __forceinline__ void phase_s15(const Params& p, int l, int rank, int nranks) {
    for (int idx = rank * 512 + otid(); idx < 40960; idx += nranks * 512) {
        const int ch = idx & 1023, sd = idx >> 10, dir = sd & 1, seq = sd >> 1;
        if (nranks < 0) continue;
        const int first = seq < 16 ? seq * 16 : 256 + (seq - 16) * 128, n = seq < 16 ? 16 : 128;
        float h = seq < 16 ? 0.f : p.state_lru[(size_t)(((seq - 16) * 4 + l) * 2 + dir) * 1024 + ch];
        const f32x2* S = (const f32x2*)(p.ws + WS_SUMM) + (size_t)(dir * NCH) * 1024 + ch;
        float* C = (float*)(p.ws + WS_CARRY) + (size_t)(dir * NCH) * 1024 + ch;
        if (dir == 0) {
#pragma unroll 8
            for (int cc = first; cc < first + n; ++cc) { C[(size_t)cc * 1024] = h; const f32x2 s = S[(size_t)cc * 1024]; h = s.x * h + s.y; }
        } else {
#pragma unroll 8
            for (int cc = first + n - 1; cc >= first; --cc) { C[(size_t)cc * 1024] = h; const f32x2 s = S[(size_t)cc * 1024]; h = s.x * h + s.y; }
        }
        if (seq < 16) p.out[(size_t)T * 1024 + (size_t)((seq * 4 + l) * 2 + dir) * 1024 + ch] = h;
    }
}
__device__ __forceinline__ void phase_s15_ctx(const Params& p, int l, int rank, int nranks) {
    for (int idx = rank * 512 + otid(); idx < 32768; idx += nranks * 512) {
        const int ch = idx & 1023, sd = idx >> 10, dir = sd & 1, seq = sd >> 1, first = seq * 16;
        const f32x2* S = (const f32x2*)(p.ws + WS_SUMM) + (size_t)(dir * NCH + first) * 1024 + ch;
        float* C = (float*)(p.ws + WS_CARRY) + (size_t)(dir * NCH + first) * 1024 + ch;
        f32x2 sm[16];
#pragma unroll
        for (int k = 0; k < 16; ++k) sm[k] = S[(size_t)k * 1024];
        float h = 0.f;
        if (dir == 0) {
#pragma unroll
            for (int k = 0; k < 16; ++k) { C[(size_t)k * 1024] = h; h = sm[k].x * h + sm[k].y; }
        } else {
#pragma unroll
            for (int k = 15; k >= 0; --k) { C[(size_t)k * 1024] = h; h = sm[k].x * h + sm[k].y; }
        }
        p.out[(size_t)T * 1024 + (size_t)((seq * 4 + l) * 2 + dir) * 1024 + ch] = h;
    }
}
__device__ __forceinline__ void phase_s15_lat(const Params& p, int l, int rank, int nranks, LAS unsigned char* lds) {
    const int tid = otid(), g = tid >> 6, cl = tid & 63;
    LAS f32x2* gs = (LAS f32x2*)lds;
    for (int it = rank; it < 128; it += nranks) {
        const int slice = it & 15, dir = (it >> 4) & 1, sq = it >> 5, ch = slice * 64 + cl;
        const int first = 256 + sq * 128;
        const int c0 = dir == 0 ? first + g * 16 : first + 127 - g * 16, cs = dir == 0 ? 1 : -1;
        const f32x2* S = (const f32x2*)(p.ws + WS_SUMM) + (size_t)(dir * NCH) * 1024 + ch;
        float* C = (float*)(p.ws + WS_CARRY) + (size_t)(dir * NCH) * 1024 + ch;
        f32x2 sm[16];
#pragma unroll
        for (int k = 0; k < 16; ++k) sm[k] = S[(size_t)(c0 + cs * k) * 1024];
        float P = 1.f, Q = 0.f;
#pragma unroll
        for (int k = 0; k < 16; ++k) { P *= sm[k].x; Q = sm[k].x * Q + sm[k].y; }
        __syncthreads();
        gs[g * 64 + cl] = (f32x2){P, Q};
        __syncthreads();
        float h = p.state_lru[(size_t)((sq * 4 + l) * 2 + dir) * 1024 + ch];
        for (int gg = 0; gg < g; ++gg) { const f32x2 s = gs[gg * 64 + cl]; h = s.x * h + s.y; }
#pragma unroll
        for (int k = 0; k < 16; ++k) { C[(size_t)(c0 + cs * k) * 1024] = h; h = sm[k].x * h + sm[k].y; }
    }
}
__device__ __forceinline__ void phase_s2(const Params& p) {
    const int tid = otid(), G = gridDim.x;
    unsigned cF[16], cG[16]; f32x2 cf, cb;
    int ci = obid();
    if (ci < NCH) { const size_t t0 = (size_t)ci * 16;
        const unsigned* laF = (const unsigned*)(p.ws + WS_LA + t0 * 1024 * 2) + tid; const unsigned* bbF = (const unsigned*)(p.ws + WS_BB + t0 * 1024 * 2) + tid;
        cf = *((const f32x2*)((const float*)(p.ws + WS_CARRY) + (size_t)ci * 1024) + tid); cb = *((const f32x2*)((const float*)(p.ws + WS_CARRY) + (size_t)(NCH + ci) * 1024) + tid);
#pragma unroll
        for (int j = 0; j < 16; ++j) { cF[j] = laF[j * 512]; cG[j] = bbF[j * 512]; } }
    for (; ci < NCH; ci += G) {
        const size_t tok0 = (size_t)ci * 16;
        const unsigned* laB = (const unsigned*)(p.ws + WS_LA + ((size_t)T + tok0) * 1024 * 2) + tid;
        const unsigned* bbB = (const unsigned*)(p.ws + WS_BB + ((size_t)T + tok0) * 1024 * 2) + tid;
        const unsigned* gy = (const unsigned*)(p.ws + WS_GY + tok0 * 1024 * 2) + tid;
        unsigned* rg = (unsigned*)(p.ws + WS_RGFF + tok0 * 1536 * 2) + tid;
        unsigned cH[16], cI[16], cY[16];
#pragma unroll
        for (int j = 0; j < 16; ++j) { cH[j] = laB[j * 512]; cI[j] = bbB[j * 512]; cY[j] = gy[j * 512]; }
        float h0 = cf.x, h1 = cf.y; float hf0[16], hf1[16];
#pragma unroll
        for (int j = 0; j < 16; ++j) { const unsigned l2 = cF[j], b2 = cG[j];
            h0 = __expf(bf_lo(l2)) * h0 + bf_lo(b2); h1 = __expf(bf_hi(l2)) * h1 + bf_hi(b2); hf0[j] = h0; hf1[j] = h1; }
        const f32x2 cbk = cb;
        const int nx = ci + G;
        if (nx < NCH) { const size_t t0 = (size_t)nx * 16;
            const unsigned* laF = (const unsigned*)(p.ws + WS_LA + t0 * 1024 * 2) + tid; const unsigned* bbF = (const unsigned*)(p.ws + WS_BB + t0 * 1024 * 2) + tid;
            cf = *((const f32x2*)((const float*)(p.ws + WS_CARRY) + (size_t)nx * 1024) + tid); cb = *((const f32x2*)((const float*)(p.ws + WS_CARRY) + (size_t)(NCH + nx) * 1024) + tid);
#pragma unroll
            for (int j = 0; j < 16; ++j) { cF[j] = laF[j * 512]; cG[j] = bbF[j * 512]; } }
        h0 = cbk.x; h1 = cbk.y;
#pragma unroll
        for (int j = 15; j >= 0; --j) { const unsigned l2 = cH[j], b2 = cI[j], g2 = cY[j];
            h0 = __expf(bf_lo(l2)) * h0 + bf_lo(b2); h1 = __expf(bf_hi(l2)) * h1 + bf_hi(b2);
            rg[j * 768] = cvt_pk_bf16((hf0[j] + h0) * bf_lo(g2), (hf1[j] + h1) * bf_hi(g2)); }
    }
    const bf16_t* ffp = (const bf16_t*)(p.ws + WS_FFP);
    bf16_t* ff = (bf16_t*)(p.ws + WS_RGFF);
#pragma unroll 4
    for (int i = obid() * 512 + tid; i < 8192 * 64; i += gridDim.x * 512) {
        const int tok = i >> 6, c8 = (i & 63) * 8;
        float a[8] = {0.f, 0.f, 0.f, 0.f, 0.f, 0.f, 0.f, 0.f};
#pragma unroll
        for (int s = 0; s < 4; ++s) { const u32x4 v = *(const u32x4*)(ffp + ((size_t)s * 8192 + tok) * 512 + c8);
            a[0] += bf_lo(v.x); a[1] += bf_hi(v.x); a[2] += bf_lo(v.y); a[3] += bf_hi(v.y); a[4] += bf_lo(v.z); a[5] += bf_hi(v.z); a[6] += bf_lo(v.w); a[7] += bf_hi(v.w); }
        u32x4 w; w.x = cvt_pk_bf16(a[0], a[1]); w.y = cvt_pk_bf16(a[2], a[3]); w.z = cvt_pk_bf16(a[4], a[5]); w.w = cvt_pk_bf16(a[6], a[7]);
        *(u32x4*)(ff + (size_t)(TCTX + tok) * 1536 + 1024 + c8) = w;
    }
}

__device__ __forceinline__ void side_job(const Params& p, int j, int l, int rank, int nranks, LAS unsigned char* lds) {
    if (j == ST_K) {
        if (l > 0) phase_convert_weights(p, l, 16, rank, nranks, lds);
        if (l < 3) { __syncthreads(); phase_convert_weights(p, l + 1, 1 | 2 | 4, rank, nranks, lds); }
    } else if (j == ST_G4) {
        if (l > 0) phase_biasmod(p, (const bf16_t*)(p.ws + WS_WFFI), 5632, (const float*)(p.ws + WS_MOD) + (size_t)(l * 5 * 6 + 3) * 1024, nullptr, (float*)(p.ws + WS_BM2), 5632, rank, nranks);
    } else if (j == ST_G5) {
        if (l < 3) phase_mod(p, l + 1, l + 2, rank, nranks, lds);
    } else if (j == ST_L) {
        if (l < 3) { phase_convert_weights(p, l + 1, 8, rank, nranks, lds);
            phase_biasmod(p, (const bf16_t*)(p.ws + WS_WIN), NIN5, (const float*)(p.ws + WS_MOD) + (size_t)((l + 1) * 5 * 6) * 1024, (const float*)(p.ws + WS_BIAS), (float*)(p.ws + WS_BM1), NIN5, rank, nranks); }
    }
    __syncthreads();
}

constexpr int N_STEPS = 3 + 4 * NST;
constexpr int LDS_BYTES = STAGE_BYTES + 256 + 1024 + 16384 + 3072;
__global__ void __launch_bounds__(512, 2) fwd_kernel(Params p) {
    extern __shared__ __attribute__((aligned(16))) unsigned char shm[];
    LAS unsigned char* lds = (LAS unsigned char*)shm;
    volatile LAS unsigned* xst = (volatile LAS unsigned*)(lds + STAGE_BYTES);
    if (threadIdx.x == 0) { xst[0] = 0u; xst[1] = 0u; xst[2] = 0u; xst[3] = 0u; }
    __syncthreads();
    const XcdBarrier xb = xcd_barrier_post((unsigned*)(p.ws + WS_CTL), xst);
    for (int s = p.st_lo; s < p.st_hi; ++s) {
        if (s == 0) phase_prep(p, lds);
        else if (s == 1) { phase_a0(p);
            phase_biasmod(p, (const bf16_t*)(p.ws + WS_WIN), NIN5, (const float*)(p.ws + WS_MOD), (const float*)(p.ws + WS_BIAS), (float*)(p.ws + WS_BM1), NIN5, obid(), gridDim.x);
            phase_biasmod(p, (const bf16_t*)(p.ws + WS_WFFI), 5632, (const float*)(p.ws + WS_MOD) + (size_t)3 * 1024, nullptr, (float*)(p.ws + WS_BM2), 5632, obid(), gridDim.x); }
        else if (s == N_STEPS - 1) phase_final(p);
        else {
            const int l = (s - 2) / NST, j = (s - 2) % NST;
            int lda = 0, ldb = 0, gstep = j;
            switch (j) {
            case ST_C: phase_conv(p, l); break;
            case ST_S1: phase_s1(p); break;
            case ST_S15:
                if (gridDim.x >= 224) { const int b = obid();
                    if (b < 128) phase_s15_lat(p, l, b, 128, lds);
                    else if (b < 192) phase_s15_ctx(p, l, b - 128, 64);
                    else if (b < 224) { lda = 4096; ldb = YLD; gstep = ST_D2C; }
                    __syncthreads(); }
                else phase_s15(p, l, obid(), (int)gridDim.x);
                break;
            case ST_S2: phase_s2(p); break;
            case ST_B: case ST_G5: case ST_K: lda = 1024; ldb = 1024; break;
            case ST_D1: lda = 1024; ldb = 256; break;
            case ST_D2: lda = 4096; ldb = YLD; break;
            case ST_G4: lda = 1536; ldb = 1536; break;
            case ST_L: lda = DFF; ldb = DFF; break;
            default: break;
            }
            if (lda) {
                const bool has_side = (j == ST_G4 || j == ST_G5 || j == ST_L);
                const int G = gridDim.x, lo = (j == ST_K) ? 32 : 192;
                const bool idle = G > 192 && obid() >= lo;
                if ((has_side || j == ST_K) && (idle || G <= 192)) side_job(p, j, l, idle ? obid() - lo : obid(), idle ? G - lo : G, lds);
                if (!(has_side && idle)) { gemm_phase(lds, p, gstep, l, lda, ldb); __syncthreads(); }
            }
            if (j == ST_D1 && s + 1 < p.st_hi) continue;
        }
#if COOP
        if (s + 1 < p.st_hi) {
            if (s == 0) cg::this_grid().sync();
            else xcd_barrier(xb);
        }
#endif
    }
}

extern "C" void kernel_launch(void* const* d_in, const int* in_sizes, int n_in, void* d_out, int out_size, void* d_ws, size_t ws_size, hipStream_t stream) {
    static int grid = 0;
    if (grid == 0) {
        if (n_in != 24 || ws_size < WS_END) { fprintf(stderr, "kernel_launch: unexpected n_in %d or workspace %zu < %zu\n", n_in, ws_size, (size_t)WS_END); grid = -1; return; }
        int dev = 0, cus = 0, per_cu = 0;
        hipGetDevice(&dev);
        hipDeviceGetAttribute(&cus, hipDeviceAttributeMultiprocessorCount, dev);
        if (hipFuncSetAttribute((const void*)fwd_kernel, hipFuncAttributeMaxDynamicSharedMemorySize, LDS_BYTES) != hipSuccess) { fprintf(stderr, "hipFuncSetAttribute failed\n"); grid = -1; return; }
        hipOccupancyMaxActiveBlocksPerMultiprocessor(&per_cu, (const void*)fwd_kernel, 512, LDS_BYTES);
        if (per_cu < 1) { fprintf(stderr, "occupancy query says %d blocks per CU\n", per_cu); per_cu = 1; }
        (void)hipGetLastError();
        grid = cus * 1;
    }
    if (grid < 0) return;
    if (hipMemsetAsync((char*)d_ws + WS_CTL, 0, XCD_BAR_WORDS * 4, stream) != hipSuccess) { fprintf(stderr, "memset failed\n"); return; }
    Params p{};
    const float** f = (const float**)&p;
    for (int i = 0; i < 24; ++i) f[i] = (const float*)d_in[i];
    p.out = (float*)d_out; p.ws = (unsigned char*)d_ws;
#if COOP
    p.st_lo = 0; p.st_hi = N_STEPS;
    void* args[] = {&p};
    hipError_t e = hipLaunchCooperativeKernel((const void*)fwd_kernel, dim3(grid), dim3(512), args, LDS_BYTES, stream);
    if (e != hipSuccess) fprintf(stderr, "cooperative launch failed: %s (grid %d)\n", hipGetErrorString(e), grid);
#else
    for (int s = 0; s < N_STEPS; ++s) {
        p.st_lo = s; p.st_hi = s + 1;
        hipLaunchKernelGGL(fwd_kernel, dim3(grid), dim3(512), LDS_BYTES, stream, p);
    }
#endif
}
```
